# Optimizing an MI355X kernel written in HIP

```python
import jax, jax.numpy as jnp
from jax import lax
import numpy as np

D_MODEL = 1024
BATCH = 32
SEQ = 2048
DEPTH = 1
DEC_BATCH = 8
DEC_SEQ = 8192
PAST_LEN = 128

N_META = 16
D_MIX = D_MODEL
HG_WIDTH = D_MIX // 2
HG_HEADS = 4
HG_HEAD_DIM = HG_WIDTH // HG_HEADS
CONV_WIDTH = D_MIX - HG_WIDTH
CONV_KERNEL = 31
CONV_PAD = (CONV_KERNEL - 1) // 2
CHUNK = 32
META_PAD = (-N_META) % CHUNK
D_FF = 2816
FFN_RES = 0.5
Z_WIDTH = 5 * HG_WIDTH + 2 * CONV_WIDTH
RMS_EPS = 1e-6
LN_EPS = 1e-5

kernel_name = 'hymba_hgrn2_conformer_encoder'


def rmsnorm(x, g):
    xf = x.astype(jnp.float32)
    y = xf * lax.rsqrt(jnp.mean(xf * xf, axis=-1, keepdims=True) + RMS_EPS)
    return (y * g.astype(jnp.float32)).astype(x.dtype)


def layernorm(x, g, b):
    xf = x.astype(jnp.float32)
    mu = jnp.mean(xf, axis=-1, keepdims=True)
    xc = xf - mu
    y = xc * lax.rsqrt(jnp.mean(xc * xc, axis=-1, keepdims=True) + LN_EPS)
    return (y * g.astype(jnp.float32) + b.astype(jnp.float32)).astype(x.dtype)


def swiglu(x, w_gate, w_up, w_down):
    return (jax.nn.silu(x @ w_gate) * (x @ w_up)) @ w_down


def gla_chunk_scan(q, k, v, logf):
    n, nh, length, dk = q.shape
    dv = v.shape[-1]
    nc = length // CHUNK

    def to_chunks(a):
        return a.astype(jnp.float32).reshape(n, nh, nc, CHUNK, a.shape[-1]).transpose(2, 0, 1, 3, 4)

    qc, kc, vc, gc = to_chunks(q), to_chunks(k), to_chunks(v), to_chunks(logf)
    tri = jnp.tril(jnp.ones((CHUNK, CHUNK), dtype=bool))

    def step(state, blk):
        qb, kb, vb, gb = blk
        b = jnp.cumsum(gb, axis=2)
        b_last = b[:, :, -1:, :]
        o_inter = jnp.einsum('nhtk,nhkv->nhtv', qb * jnp.exp(b), state)
        diff = b[:, :, :, None, :] - b[:, :, None, :, :]
        decay = jnp.exp(jnp.where(tri[:, :, None], diff, -jnp.inf))
        scores = jnp.einsum('nhtk,nhsk,nhtsk->nhts', qb, kb, decay)
        o_intra = jnp.einsum('nhts,nhsv->nhtv', scores, vb)
        new_state = (jnp.exp(b_last[:, :, 0, :, None]) * state
                     + jnp.einsum('nhsk,nhsv->nhkv', kb * jnp.exp(b_last - b), vb))
        return new_state, o_inter + o_intra

    s0 = jnp.zeros((n, nh, dk, dv), jnp.float32)
    _, out = lax.scan(step, s0, (qc, kc, vc, gc))
    return out.transpose(1, 2, 0, 3, 4).reshape(n, nh, length, dv)


def depthwise_conv(u, w, b):
    y = lax.conv_general_dilated(u, w.astype(u.dtype)[:, None, :], window_strides=(1,),
                                 padding=[(CONV_PAD, CONV_PAD)],
                                 dimension_numbers=('NWC', 'WIO', 'NWC'),
                                 feature_group_count=u.shape[-1])
    return y + b.astype(u.dtype)


def token_mixing(u, w_in, lb, hg_norm, conv_w, conv_b, conv_ln_g, conv_ln_b, w_out):
    bsz, t, _ = u.shape
    W, C = HG_WIDTH, CONV_WIDTH
    z = u @ w_in

    def heads(a):
        return a.reshape(bsz, t, HG_HEADS, HG_HEAD_DIM).transpose(0, 2, 1, 3)

    q = jax.nn.silu(heads(z[..., 0:W])).astype(jnp.float32)
    v = heads(z[..., 3 * W:4 * W]).astype(jnp.float32)
    f_logits = jnp.stack([heads(z[..., W:2 * W]), heads(z[..., 2 * W:3 * W])]).astype(jnp.float32)
    lb = lb.reshape(2, 1, HG_HEADS, 1, HG_HEAD_DIM)
    logf = jnp.logaddexp(jnp.log(lb), jnp.log1p(-lb) + jax.nn.log_sigmoid(f_logits))
    k = -jnp.expm1(logf)

    def pad(a):
        return jnp.pad(a, ((0, 0),) * (a.ndim - 2) + ((META_PAD, 0), (0, 0)))

    def flip(a):
        return jnp.flip(a, axis=-2)

    qp, vp, kp, gp = pad(q), pad(v), pad(k), pad(logf)
    qs = jnp.concatenate([qp, flip(qp)], axis=0)
    vs = jnp.concatenate([vp, flip(vp)], axis=0)
    ks = jnp.concatenate([kp[0], flip(kp[1])], axis=0)
    gs = jnp.concatenate([gp[0], flip(gp[1])], axis=0)
    o = gla_chunk_scan(qs, ks, vs, gs)
    o = (o[:bsz] + flip(o[bsz:]))[:, :, META_PAD:]
    o = o * lax.rsqrt(jnp.mean(o * o, axis=-1, keepdims=True) + RMS_EPS)
    o = o.transpose(0, 2, 1, 3).reshape(bsz, t, W) * hg_norm.astype(jnp.float32)
    hg_out = (o * jax.nn.silu(z[..., 4 * W:5 * W].astype(jnp.float32))).astype(u.dtype)

    glu = z[..., 5 * W:5 * W + C] * jax.nn.sigmoid(z[..., 5 * W + C:5 * W + 2 * C])
    c = depthwise_conv(glu, conv_w, conv_b)
    c = jax.nn.silu(layernorm(c, conv_ln_g, conv_ln_b))

    return jnp.concatenate([hg_out, c], axis=-1) @ w_out


def encoder_trunk(x, meta_tokens, ffn1_norm, ffn1_w_gate, ffn1_w_up, ffn1_w_down, mix_norm, w_in,
                  lb_logits, hg_norm, conv_w, conv_b, conv_ln_g, conv_ln_b, w_out,
                  ffn2_norm, ffn2_w_gate, ffn2_w_up, ffn2_w_down, final_norm):
    bsz = x.shape[0]
    meta = jnp.broadcast_to(meta_tokens[None].astype(x.dtype), (bsz, N_META, x.shape[-1]))
    h = jnp.concatenate([meta, x], axis=1)
    lb_all = jnp.cumsum(jax.nn.softmax(lb_logits.astype(jnp.float32), axis=0), axis=0)
    for layer in range(DEPTH):
        h = h + FFN_RES * swiglu(rmsnorm(h, ffn1_norm[layer]), ffn1_w_gate[layer], ffn1_w_up[layer], ffn1_w_down[layer])
        h = h + token_mixing(rmsnorm(h, mix_norm[layer]), w_in[layer], lb_all[layer], hg_norm[layer],
                             conv_w[layer], conv_b[layer], conv_ln_g[layer], conv_ln_b[layer], w_out[layer])
        h = h + FFN_RES * swiglu(rmsnorm(h, ffn2_norm[layer]), ffn2_w_gate[layer], ffn2_w_up[layer], ffn2_w_down[layer])
    return rmsnorm(h, final_norm)[:, N_META:]


def setup_inputs(seed: int = 0) -> dict:
    key = jax.random.key(seed)
    ks = jax.random.split(key, 24)
    f32 = jnp.float32

    def nrm(k, shape, scale):
        return jax.random.normal(k, shape, f32) * scale

    def gain(k, shape):
        return 1.0 + 0.02 * jax.random.normal(k, shape, f32)

    return {
        'x_prompt': nrm(ks[0], (BATCH, SEQ, D_MODEL), 1.0),
        'x_sample': nrm(ks[1], (DEC_BATCH, DEC_SEQ, D_MODEL), 1.0),
        'meta_tokens': nrm(ks[2], (N_META, D_MODEL), 1.0),
        'ffn1_norm': gain(ks[3], (DEPTH, D_MODEL)),
        'ffn1_w_gate': nrm(ks[4], (DEPTH, D_MODEL, D_FF), D_MODEL ** -0.5),
        'ffn1_w_up': nrm(ks[5], (DEPTH, D_MODEL, D_FF), D_MODEL ** -0.5),
        'ffn1_w_down': nrm(ks[6], (DEPTH, D_FF, D_MODEL), D_FF ** -0.5),
        'mix_norm': gain(ks[7], (DEPTH, D_MODEL)),
        'w_in': nrm(ks[8], (DEPTH, D_MODEL, Z_WIDTH), D_MODEL ** -0.5),
        'lb_logits': nrm(ks[9], (DEPTH + 1, 2, HG_WIDTH), 0.5),
        'hg_norm': gain(ks[10], (DEPTH, HG_WIDTH)),
        'conv_w': nrm(ks[11], (DEPTH, CONV_KERNEL, CONV_WIDTH), CONV_KERNEL ** -0.5),
        'conv_b': nrm(ks[12], (DEPTH, CONV_WIDTH), 0.02),
        'conv_ln_g': gain(ks[13], (DEPTH, CONV_WIDTH)),
        'conv_ln_b': nrm(ks[14], (DEPTH, CONV_WIDTH), 0.02),
        'w_out': nrm(ks[15], (DEPTH, D_MIX, D_MODEL), D_MIX ** -0.5),
        'ffn2_norm': gain(ks[16], (DEPTH, D_MODEL)),
        'ffn2_w_gate': nrm(ks[17], (DEPTH, D_MODEL, D_FF), D_MODEL ** -0.5),
        'ffn2_w_up': nrm(ks[18], (DEPTH, D_MODEL, D_FF), D_MODEL ** -0.5),
        'ffn2_w_down': nrm(ks[19], (DEPTH, D_FF, D_MODEL), D_FF ** -0.5),
        'final_norm': gain(ks[20], (D_MODEL,)),
    }


def reference(x_prompt, x_sample, meta_tokens, ffn1_norm, ffn1_w_gate, ffn1_w_up, ffn1_w_down,
              mix_norm, w_in, lb_logits, hg_norm, conv_w, conv_b, conv_ln_g, conv_ln_b, w_out,
              ffn2_norm, ffn2_w_gate, ffn2_w_up, ffn2_w_down, final_norm):
    y_prompt = encoder_trunk(x_prompt, meta_tokens, ffn1_norm, ffn1_w_gate, ffn1_w_up, ffn1_w_down,
                             mix_norm, w_in, lb_logits, hg_norm, conv_w, conv_b, conv_ln_g, conv_ln_b,
                             w_out, ffn2_norm, ffn2_w_gate, ffn2_w_up, ffn2_w_down, final_norm)
    y_sample = encoder_trunk(x_sample, meta_tokens, ffn1_norm, ffn1_w_gate, ffn1_w_up, ffn1_w_down,
                             mix_norm, w_in, lb_logits, hg_norm, conv_w, conv_b, conv_ln_g, conv_ln_b,
                             w_out, ffn2_norm, ffn2_w_gate, ffn2_w_up, ffn2_w_down, final_norm)
    return (y_prompt, y_sample)
```

```cpp
#include <hip/hip_runtime.h>
#include <hip/hip_cooperative_groups.h>
#include <cstdio>
namespace cg = cooperative_groups;

#define LAS __attribute__((address_space(3)))
typedef unsigned short bf16_t;
typedef short bf16x8 __attribute__((ext_vector_type(8)));
typedef float f32x4 __attribute__((ext_vector_type(4)));
typedef unsigned u32x4 __attribute__((ext_vector_type(4)));
typedef unsigned u32x2 __attribute__((ext_vector_type(2)));

#define NAIVE_SCAN 1
#ifndef COOP
#define COOP 1
#endif

constexpr int D = 1024, FF = 2816;
constexpr int LP = 2080, LS = 8224;
constexpr int RP = 32 * LP;
constexpr int R = RP + 8 * LS;
constexpr int NTHREADS = 512;
constexpr float RMS_EPS = 1e-6f, LN_EPS = 1e-5f;

constexpr size_t SZ_W1 = (size_t)5632 * 1024 * 2, SZ_W2 = (size_t)1024 * 2816 * 2, SZ_W3A = (size_t)2048 * 1024 * 2, SZ_W3B = (size_t)1536 * 1024 * 2, SZ_W4 = (size_t)1024 * 1024 * 2;
constexpr size_t OFF_W1 = 0, OFF_W2 = OFF_W1 + SZ_W1, OFF_W3A = OFF_W2 + SZ_W2, OFF_W3B = OFF_W3A + SZ_W3A, OFF_W4 = OFF_W3B + SZ_W3B, OFF_W5 = OFF_W4 + SZ_W4, OFF_W6 = OFF_W5 + SZ_W1;
constexpr size_t OFF_SS = OFF_W6 + SZ_W2;
constexpr size_t OFF_LB = OFF_SS + (size_t)4 * R * 4;
constexpr size_t OFF_X = OFF_LB + 4096;
constexpr size_t OFF_Y = OFF_X + (size_t)R * 1024 * 2;
constexpr size_t WS_END = OFF_Y + (size_t)R * 2816 * 2;
constexpr size_t Y_Q = 0, Y_V = (size_t)R * 1024, Y_LFO = (size_t)2 * R * 1024;

struct Params { const float* in[21]; float* out; unsigned char* ws; int ph_lo, ph_hi; };

__device__ __forceinline__ unsigned cvt_pk_bf16(float lo, float hi) { unsigned r; asm("v_cvt_pk_bf16_f32 %0, %1, %2" : "=v"(r) : "v"(lo), "v"(hi)); return r; }
__device__ __forceinline__ float bf2f(unsigned short b) { return __uint_as_float(((unsigned)b) << 16); }
__device__ __forceinline__ float bflo(unsigned w) { return __uint_as_float(w << 16); }
__device__ __forceinline__ float bfhi(unsigned w) { return __uint_as_float(w & 0xffff0000u); }
__device__ __forceinline__ unsigned short f2h(float f) { return __builtin_bit_cast(unsigned short, (_Float16)f); }
__device__ __forceinline__ float h2f(unsigned short h) { return (float)__builtin_bit_cast(_Float16, h); }
__device__ __forceinline__ float sigmoidf_(float x) { return __builtin_amdgcn_rcpf(1.0f + __expf(-x)); }
__device__ __forceinline__ float siluf_(float x) { return x * sigmoidf_(x); }
__device__ __forceinline__ void row_info(int r, int& seq, int& pos) {
    if (r < RP) { seq = r / LP; pos = r - seq * LP; } else { const int q = (r - RP) / LS; seq = 32 + q; pos = (r - RP) - q * LS; }
}

namespace pg8 {
constexpr int BM = 256, BK = 64, HALF = 128, HTB = HALF * BK * 2, STAGE_BYTES = 8 * HTB, NXCD = 8, WGM = 8;
__host__ __device__ __forceinline__ int lds_byte(int r, int c) { const int st = (r >> 4) * 2 + (c >> 5), rr = r & 15, cc = c & 31, ob = rr * 64 + cc * 2; return st * 1024 + (ob ^ (((ob >> 9) & 1) << 5)); }
__host__ __device__ __forceinline__ void stage_rc(int b, int& Rr, int& C) { const int st = b / 1024, sb = b % 1024, swz = sb ^ (((sb >> 9) & 1) << 5); Rr = (st >> 1) * 16 + swz / 64; C = (st & 1) * 32 + (swz % 64) / 2; }
__host__ __device__ __forceinline__ int perm32(int rho) { const int n = rho >> 4, i = rho & 15; return 8 * (i >> 2) + 4 * n + (i & 3); }
struct Unit { int pm, pn; };
struct StaticOrder {
    int nM, nN, nwg, G, c;
    __device__ void init(int M, int N, int G_, int c_) { nM = M / BM; nN = N / BM; nwg = nM * nN; G = G_; c = c_; }
    __device__ bool next(int i, Unit& u) const {
        const long L = (long)i * G + c; if (L >= nwg) return false;
        int wgid = (int)L; { const int q = nwg / NXCD, r = nwg % NXCD, xcd = wgid % NXCD, off = wgid / NXCD; wgid = (xcd < r ? xcd * (q + 1) : r * (q + 1) + (xcd - r) * q) + off; }
        const int nig = WGM * nN, gid = wgid / nig, fm = gid * WGM, gsz = (nM - fm) < WGM ? (nM - fm) : WGM;
        u.pm = fm + ((wgid % nig) % gsz); u.pn = (wgid % nig) / gsz; return true;
    }
};
template <class Epi>
__device__ __forceinline__ void gemm_phase(LAS unsigned char* lds, const bf16_t* A, const bf16_t* Bt, int M, int N, int K, const Epi& E) {
    const int tid = threadIdx.x, wid = __builtin_amdgcn_readfirstlane(tid >> 6), lane = tid & 63, wr = wid >> 2, wc = wid & 3, fr = lane & 15, fq = lane >> 4;
    const int nt = K / BK;
    StaticOrder S; S.init(M, N, (int)gridDim.x, (int)blockIdx.x);
    unsigned voffA[2], voffB[2];
#pragma unroll
    for (int i = 0; i < 2; ++i) { int Rr, C; stage_rc(tid * 16 + i * 8192, Rr, C); const int Rb = (Rr & ~31) + perm32(Rr & 31);
        voffA[i] = (unsigned)(Rr * K + C) * 2u; voffB[i] = (unsigned)(Rb * K + C) * 2u; }
    const size_t kstep = (size_t)(BK * 2);
    const size_t hstep = (size_t)HALF * K * 2;
    const size_t tstep = 2 * hstep;
    const unsigned ldsw = (unsigned)wid * 1024u;
    const int aoff = lds_byte(wr * 64 + fr, fq * 8), boff = lds_byte(wc * 32 + fr, fq * 8);
#define PG8_SA(b, h) (((b) * 2 + (h)) * HTB)
#define PG8_SB(b, h) ((4 + (b) * 2 + (h)) * HTB)
#define PG8_STAGE(bufoff, gbase, voff) do { _Pragma("unroll") for (int _i = 0; _i < 2; ++_i) \
        __builtin_amdgcn_global_load_lds((const unsigned*)((const char*)(gbase) + (voff)[_i]), (LAS unsigned*)(lds + (bufoff) + ldsw + _i * 8192), 16, 0, 0); } while (0)
#define PG8_LDA(dst, b, h) do { _Pragma("unroll") for (int m = 0; m < 4; ++m) _Pragma("unroll") for (int k = 0; k < 2; ++k) dst[m][k] = *(const LAS bf16x8*)(lds + PG8_SA(b, h) + aoff + m * 2048 + k * 1024); } while (0)
#define PG8_LDB(dst, b, h) do { _Pragma("unroll") for (int n = 0; n < 2; ++n) _Pragma("unroll") for (int k = 0; k < 2; ++k) dst[n][k] = *(const LAS bf16x8*)(lds + PG8_SB(b, h) + boff + n * 2048 + k * 1024); } while (0)
#define PG8_MMA(ai, bj, At, Bt_) do { __builtin_amdgcn_s_setprio(1); _Pragma("unroll") for (int m = 0; m < 4; ++m) _Pragma("unroll") for (int n = 0; n < 2; ++n) _Pragma("unroll") for (int k = 0; k < 2; ++k) \
        acc[ai][bj][m][n] = __builtin_amdgcn_mfma_f32_16x16x32_bf16(Bt_[n][k], At[m][k], acc[ai][bj][m][n], 0, 0, 0); __builtin_amdgcn_s_setprio(0); } while (0)
#define PG8_WAIT_V(n) asm volatile("s_waitcnt vmcnt(" #n ")" ::: "memory")
#define PG8_WAIT_L(n) asm volatile("s_waitcnt lgkmcnt(" #n ")" ::: "memory")
#define PG8_BAR __builtin_amdgcn_s_barrier()
#define PG8_SCHED __builtin_amdgcn_sched_barrier(0)
    Unit cur, nxt; int ui = 0;
    if (!S.next(0, cur)) return;
    f32x4 acc[2][2][4][2];
#pragma unroll
    for (int a = 0; a < 2; ++a)
#pragma unroll
        for (int b = 0; b < 2; ++b)
#pragma unroll
            for (int m = 0; m < 4; ++m)
#pragma unroll
                for (int n = 0; n < 2; ++n) acc[a][b][m][n] = (f32x4){0.f, 0.f, 0.f, 0.f};
    bf16x8 At[4][2], B0[2][2], B1[2][2];
    const char* cA = (const char*)A + (size_t)cur.pm * tstep; const char* cB = (const char*)Bt + (size_t)cur.pn * tstep;
    PG8_STAGE(PG8_SB(0, 0), cB, voffB); PG8_STAGE(PG8_SA(0, 0), cA, voffA); PG8_STAGE(PG8_SB(0, 1), cB + hstep, voffB); PG8_STAGE(PG8_SA(0, 1), cA + hstep, voffA);
    if (wr == 1) PG8_BAR;
    PG8_WAIT_V(4); PG8_BAR;
    PG8_STAGE(PG8_SB(1, 0), cB + kstep, voffB); PG8_STAGE(PG8_SA(1, 0), cA + kstep, voffA); PG8_STAGE(PG8_SB(1, 1), cB + hstep + kstep, voffB);
    PG8_WAIT_V(6); PG8_BAR;
    for (;;) {
        const bool has_next = S.next(ui + 1, nxt);
        const char* nA = has_next ? (const char*)A + (size_t)nxt.pm * tstep : cA; const char* nB = has_next ? (const char*)Bt + (size_t)nxt.pn * tstep : cB;
        for (int t = 0; t < nt; t += 2) {
            const bool last = (t == nt - 2);
            const char* a1 = cA + (size_t)(t + 1) * kstep;
            const char* a2 = last ? nA : cA + (size_t)(t + 2) * kstep; const char* b2 = last ? nB : cB + (size_t)(t + 2) * kstep;
            const char* a3 = a2 + kstep; const char* b3 = b2 + kstep;
            PG8_LDB(B0, 0, 0); PG8_SCHED; PG8_LDA(At, 0, 0); PG8_STAGE(PG8_SA(1, 1), a1 + hstep, voffA);
            PG8_WAIT_L(8); PG8_BAR; PG8_WAIT_L(0); PG8_MMA(0, 0, At, B0); PG8_BAR; PG8_SCHED;
            PG8_LDB(B1, 0, 1); PG8_STAGE(PG8_SB(0, 0), b2, voffB);
            PG8_BAR; PG8_WAIT_L(0); PG8_MMA(0, 1, At, B1); PG8_BAR;
            PG8_LDA(At, 0, 1); PG8_STAGE(PG8_SA(0, 0), a2, voffA);
            PG8_BAR; PG8_WAIT_L(0); PG8_MMA(1, 0, At, B0); PG8_BAR; PG8_SCHED;
            PG8_STAGE(PG8_SB(0, 1), b2 + hstep, voffB);
            PG8_WAIT_V(6); PG8_BAR; PG8_MMA(1, 1, At, B1); PG8_BAR;
            PG8_LDB(B0, 1, 0); PG8_SCHED; PG8_LDA(At, 1, 0); PG8_STAGE(PG8_SA(0, 1), a2 + hstep, voffA);
            PG8_WAIT_L(8); PG8_BAR; PG8_WAIT_L(0); PG8_MMA(0, 0, At, B0); PG8_BAR; PG8_SCHED;
            PG8_LDB(B1, 1, 1); PG8_STAGE(PG8_SB(1, 0), b3, voffB);
            PG8_BAR; PG8_WAIT_L(0); PG8_MMA(0, 1, At, B1); PG8_BAR;
            PG8_LDA(At, 1, 1); PG8_STAGE(PG8_SA(1, 0), a3, voffA);
            PG8_BAR; PG8_WAIT_L(0); PG8_MMA(1, 0, At, B0); PG8_BAR; PG8_SCHED;
            PG8_STAGE(PG8_SB(1, 1), b3 + hstep, voffB);
            PG8_WAIT_V(6); PG8_BAR; PG8_MMA(1, 1, At, B1); PG8_BAR;
        }
        E(acc, cur, wr, wc, fr, fq);
        if (!has_next) break;
#pragma unroll
        for (int a = 0; a < 2; ++a)
#pragma unroll
            for (int b = 0; b < 2; ++b)
#pragma unroll
                for (int m = 0; m < 4; ++m)
#pragma unroll
                    for (int n = 0; n < 2; ++n) acc[a][b][m][n] = (f32x4){0.f, 0.f, 0.f, 0.f};
        cur = nxt; cA = nA; cB = nB; ++ui;
    }
    PG8_WAIT_V(0);
    if (wr == 0) PG8_BAR;
    PG8_BAR;
#undef PG8_SA
#undef PG8_SB
#undef PG8_STAGE
#undef PG8_LDA
#undef PG8_LDB
#undef PG8_MMA
#undef PG8_WAIT_V
#undef PG8_WAIT_L
#undef PG8_BAR
#undef PG8_SCHED
}
}
using pg8::Unit;
typedef f32x4 Acc[2][2][4][2];

template <int MODE> struct EpiPair {
    bf16_t* O; int ldo; int pn0; const float* ss;
    __device__ __forceinline__ void operator()(const Acc& acc, const Unit& u, int wr, int wc, int fr, int fq) const {
        const int col = (u.pn - pn0) * 128 + wc * 32 + fq * 8;
#pragma unroll
        for (int ai = 0; ai < 2; ++ai)
#pragma unroll
            for (int m = 0; m < 4; ++m) {
                const int r = u.pm * 256 + ai * 128 + wr * 64 + m * 16 + fr;
                const float s = __builtin_amdgcn_rsqf(ss[r] * (1.0f / 1024.0f) + RMS_EPS);
                float o[8];
#pragma unroll
                for (int n = 0; n < 2; ++n)
#pragma unroll
                    for (int j = 0; j < 4; ++j) { const float a = acc[ai][0][m][n][j] * s, b = acc[ai][1][m][n][j] * s; o[n * 4 + j] = MODE == 0 ? siluf_(a) * b : a * sigmoidf_(b); }
                u32x4 w; w.x = cvt_pk_bf16(o[0], o[1]); w.y = cvt_pk_bf16(o[2], o[3]); w.z = cvt_pk_bf16(o[4], o[5]); w.w = cvt_pk_bf16(o[6], o[7]);
                *(u32x4*)(O + (size_t)r * ldo + col) = w;
            }
    }
};
template <int MODE> struct EpiRes {
    const float* xp; const float* xs; const float* meta; float* out; bf16_t* hb; float* ss;
    __device__ __forceinline__ void operator()(const Acc& acc, const Unit& u, int wr, int wc, int fr, int fq) const {
        const int col0 = u.pn * 256 + wc * 32 + fq * 8;
        const float sc = (MODE == 1) ? 1.0f : 0.5f;
#pragma unroll
        for (int ai = 0; ai < 2; ++ai)
#pragma unroll
            for (int m = 0; m < 4; ++m) {
                const int r = u.pm * 256 + ai * 128 + wr * 64 + m * 16 + fr;
                int seq, pos; row_info(r, seq, pos);
                const bool real = pos >= 32;
                const long orow = (long)r - 32 * (seq + 1);
                float* op = out + orow * 1024 + col0;
                const float* src;
                if (MODE == 0) src = real ? ((orow < 65536 ? xp + orow * 1024 : xs + (orow - 65536) * 1024) + col0) : meta + (size_t)((pos - 16) & 15) * 1024 + col0;
                else src = op;
                const bool have = (MODE == 0) ? (pos >= 16) : real;
                float sq = 0.f;
#pragma unroll
                for (int bj = 0; bj < 2; ++bj) {
                    f32x4 h0 = {0.f, 0.f, 0.f, 0.f}, h1 = {0.f, 0.f, 0.f, 0.f};
                    if (have) { h0 = *(const f32x4*)(src + bj * 128); h1 = *(const f32x4*)(src + bj * 128 + 4); }
                    f32x4 v0 = h0 + acc[ai][bj][m][0] * sc, v1 = h1 + acc[ai][bj][m][1] * sc;
                    if (MODE != 0 && !real) { v0 = (f32x4){0.f, 0.f, 0.f, 0.f}; v1 = v0; }
                    if (real) { *(f32x4*)(op + bj * 128) = v0; *(f32x4*)(op + bj * 128 + 4) = v1; }
                    if (MODE != 2) { u32x4 w; w.x = cvt_pk_bf16(v0[0], v0[1]); w.y = cvt_pk_bf16(v0[2], v0[3]); w.z = cvt_pk_bf16(v1[0], v1[1]); w.w = cvt_pk_bf16(v1[2], v1[3]);
                        *(u32x4*)(hb + (size_t)r * 1024 + col0 + bj * 128) = w; }
                    sq += (v0[0] * v0[0] + v0[1] * v0[1]) + (v0[2] * v0[2] + v0[3] * v0[3]) + (v1[0] * v1[0] + v1[1] * v1[1]) + (v1[2] * v1[2] + v1[3] * v1[3]);
                }
                sq += __shfl_xor(sq, 16); sq += __shfl_xor(sq, 32);
                if (fq == 0 && (MODE != 2 || real)) atomicAdd(ss + r, sq);
            }
    }
};
struct EpiZa {
    bf16_t* q; bf16_t* v; unsigned short* lfo; const float* ss; const float* lbv;
    __device__ __forceinline__ void operator()(const Acc& acc, const Unit& u, int wr, int wc, int fr, int fq) const {
        const int cw = wc * 32 + fq * 8;
        const int kind = u.pn < 2 ? 0 : (u.pn < 6 ? 1 : 2);
#pragma unroll
        for (int ai = 0; ai < 2; ++ai)
#pragma unroll
            for (int m = 0; m < 4; ++m) {
                const int r = u.pm * 256 + ai * 128 + wr * 64 + m * 16 + fr;
                const float s = __builtin_amdgcn_rsqf(ss[r] * (1.0f / 1024.0f) + RMS_EPS);
                int seq, pos; row_info(r, seq, pos);
#pragma unroll
                for (int bj = 0; bj < 2; ++bj) {
                    float z[8];
#pragma unroll
                    for (int n = 0; n < 2; ++n)
#pragma unroll
                        for (int j = 0; j < 4; ++j) z[n * 4 + j] = acc[ai][bj][m][n][j] * s;
                    u32x4 w;
                    if (kind == 0) {
#pragma unroll
                        for (int e = 0; e < 8; ++e) z[e] = siluf_(z[e]);
                        w.x = cvt_pk_bf16(z[0], z[1]); w.y = cvt_pk_bf16(z[2], z[3]); w.z = cvt_pk_bf16(z[4], z[5]); w.w = cvt_pk_bf16(z[6], z[7]);
                        *(u32x4*)(q + (size_t)r * 512 + u.pn * 256 + bj * 128 + cw) = w;
                    } else if (kind == 1) {
                        const int c = (u.pn - 2) * 256 + bj * 128 + cw;
                        const f32x4 l0 = *(const f32x4*)(lbv + c), l1 = *(const f32x4*)(lbv + c + 4);
                        unsigned short hh[8];
#pragma unroll
                        for (int e = 0; e < 8; ++e) { const float lb = e < 4 ? l0[e & 3] : l1[e & 3]; float f = lb + (1.0f - lb) * sigmoidf_(z[e]); if (pos < 16) f = 1.0f; hh[e] = f2h(f); }
                        w.x = hh[0] | ((unsigned)hh[1] << 16); w.y = hh[2] | ((unsigned)hh[3] << 16); w.z = hh[4] | ((unsigned)hh[5] << 16); w.w = hh[6] | ((unsigned)hh[7] << 16);
                        *(u32x4*)(lfo + (size_t)r * 1024 + c) = w;
                    } else {
                        w.x = cvt_pk_bf16(z[0], z[1]); w.y = cvt_pk_bf16(z[2], z[3]); w.z = cvt_pk_bf16(z[4], z[5]); w.w = cvt_pk_bf16(z[6], z[7]);
                        *(u32x4*)(v + (size_t)r * 512 + (u.pn - 6) * 256 + bj * 128 + cw) = w;
                    }
                }
            }
    }
};
struct EpiZb {
    bf16_t* gate; bf16_t* glu; const float* ss;
    __device__ __forceinline__ void operator()(const Acc& acc, const Unit& u, int wr, int wc, int fr, int fq) const {
        if (u.pn >= 2) { EpiPair<1> e{glu, 512, 2, ss}; e(acc, u, wr, wc, fr, fq); return; }
        const int cw = wc * 32 + fq * 8;
#pragma unroll
        for (int ai = 0; ai < 2; ++ai)
#pragma unroll
            for (int m = 0; m < 4; ++m) {
                const int r = u.pm * 256 + ai * 128 + wr * 64 + m * 16 + fr;
                const float s = __builtin_amdgcn_rsqf(ss[r] * (1.0f / 1024.0f) + RMS_EPS);
#pragma unroll
                for (int bj = 0; bj < 2; ++bj) {
                    float z[8];
#pragma unroll
                    for (int n = 0; n < 2; ++n)
#pragma unroll
                        for (int j = 0; j < 4; ++j) z[n * 4 + j] = siluf_(acc[ai][bj][m][n][j] * s);
                    u32x4 w; w.x = cvt_pk_bf16(z[0], z[1]); w.y = cvt_pk_bf16(z[2], z[3]); w.z = cvt_pk_bf16(z[4], z[5]); w.w = cvt_pk_bf16(z[6], z[7]);
                    *(u32x4*)(gate + (size_t)r * 512 + u.pn * 256 + bj * 128 + cw) = w;
                }
            }
    }
};

__device__ __forceinline__ void cvt_tile(LAS float* tile, const float* s0, const float* s1, int ld, int mode, const float* gain, bf16_t* dst, int K, int kt, int ntile) {
    const int t = threadIdx.x;
    const int n0 = ntile * 64, k0 = kt * 64;
    const float* src; int col0;
    if (mode == 0) { src = s0; col0 = n0; } else { const int pn = n0 >> 8, w = n0 & 255; src = w < 128 ? s0 : s1; col0 = pn * 128 + (w & 127); }
#pragma unroll
    for (int p = 0; p < 2; ++p) {
        const int kk = (t >> 4) + p * 32, c4 = (t & 15) * 4;
        f32x4 v = *(const f32x4*)(src + (size_t)(k0 + kk) * ld + col0 + c4);
        const float g = gain ? gain[k0 + kk] : 1.0f;
#pragma unroll
        for (int e = 0; e < 4; ++e) tile[kk * 65 + c4 + e] = v[e] * g;
    }
    __syncthreads();
    { const int n = t >> 3, k8 = (t & 7) * 8; float x[8];
#pragma unroll
      for (int j = 0; j < 8; ++j) x[j] = tile[(k8 + j) * 65 + n];
      u32x4 w; w.x = cvt_pk_bf16(x[0], x[1]); w.y = cvt_pk_bf16(x[2], x[3]); w.z = cvt_pk_bf16(x[4], x[5]); w.w = cvt_pk_bf16(x[6], x[7]);
      *(u32x4*)(dst + (size_t)(n0 + n) * K + k0 + k8) = w; }
    __syncthreads();
}
__device__ __forceinline__ void phase_prep(LAS unsigned char* lds, const Params& p) {
    unsigned char* ws = p.ws;
    LAS float* tile = (LAS float*)lds;
    const int J1 = 16 * 88, J2 = 44 * 16, J3A = 16 * 32, J3B = 16 * 24, J4 = 16 * 16;
    const int total = J1 + J2 + J3A + J3B + J4 + J1 + J2;
    for (int job = blockIdx.x; job < total; job += gridDim.x) {
        int j = job;
        const float* s0; const float* s1 = nullptr; const float* gain = nullptr; int ld, mode = 0, K, kt, nt_; bf16_t* dst;
        if (j < J1) { s0 = p.in[4]; s1 = p.in[5]; ld = FF; mode = 1; gain = p.in[3]; dst = (bf16_t*)(ws + OFF_W1); K = 1024; kt = j % 16; nt_ = j / 16; }
        else if ((j -= J1) < J2) { s0 = p.in[6]; ld = 1024; dst = (bf16_t*)(ws + OFF_W2); K = FF; kt = j % 44; nt_ = j / 44; }
        else if ((j -= J2) < J3A) { s0 = p.in[8]; ld = 3584; gain = p.in[7]; dst = (bf16_t*)(ws + OFF_W3A); K = 1024; kt = j % 16; nt_ = j / 16; }
        else if ((j -= J3A) < J3B) { ld = 3584; gain = p.in[7]; K = 1024; kt = j % 16; nt_ = j / 16;
            if (nt_ < 8) { s0 = p.in[8] + 2048; dst = (bf16_t*)(ws + OFF_W3B); }
            else { s0 = p.in[8] + 2560; s1 = p.in[8] + 3072; mode = 1; dst = (bf16_t*)(ws + OFF_W3B) + (size_t)512 * 1024; nt_ -= 8; } }
        else if ((j -= J3B) < J4) { s0 = p.in[15]; ld = 1024; dst = (bf16_t*)(ws + OFF_W4); K = 1024; kt = j % 16; nt_ = j / 16; }
        else if ((j -= J4) < J1) { s0 = p.in[17]; s1 = p.in[18]; ld = FF; mode = 1; gain = p.in[16]; dst = (bf16_t*)(ws + OFF_W5); K = 1024; kt = j % 16; nt_ = j / 16; }
        else { j -= J1; s0 = p.in[19]; ld = 1024; dst = (bf16_t*)(ws + OFF_W6); K = FF; kt = j % 44; nt_ = j / 44; }
        cvt_tile(tile, s0, s1, ld, mode, gain, dst, K, kt, nt_);
    }
    if (blockIdx.x == 0) for (int i = threadIdx.x; i < 1024; i += NTHREADS) { const float l0 = p.in[9][i], l1 = p.in[9][1024 + i]; ((float*)(ws + OFF_LB))[i] = 1.0f / (1.0f + __expf(l1 - l0)); }
    float* ss = (float*)(ws + OFF_SS);
    bf16_t* hb = (bf16_t*)(ws + OFF_X);
    const int wave = threadIdx.x >> 6, lane = threadIdx.x & 63;
    for (int r = blockIdx.x * 8 + wave; r < R; r += gridDim.x * 8) {
        int seq, pos; row_info(r, seq, pos);
        const float* src = nullptr;
        if (pos >= 32) { const long orow = (long)r - 32 * (seq + 1); src = orow < 65536 ? p.in[0] + orow * 1024 : p.in[1] + (orow - 65536) * 1024; }
        else if (pos >= 16) src = p.in[2] + (size_t)(pos - 16) * 1024;
        float sq = 0.f;
#pragma unroll
        for (int j = 0; j < 4; ++j) {
            f32x4 v = {0.f, 0.f, 0.f, 0.f};
            if (src) v = *(const f32x4*)(src + j * 256 + lane * 4);
            sq += (v[0] * v[0] + v[1] * v[1]) + (v[2] * v[2] + v[3] * v[3]);
            u32x2 w; w.x = cvt_pk_bf16(v[0], v[1]); w.y = cvt_pk_bf16(v[2], v[3]);
            *(u32x2*)(hb + (size_t)r * 1024 + j * 256 + lane * 4) = w;
        }
#pragma unroll
        for (int o = 32; o >= 1; o >>= 1) sq += __shfl_xor(sq, o);
        if (lane == 0) { ss[r] = sq; ss[R + r] = 0.f; ss[2 * R + r] = 0.f; ss[3 * R + r] = 0.f; }
    }
}

constexpr int SC_QT = 0, SC_KT = 8704, SC_KTT = 17408, SC_VT = 27648, SC_TOT = 37888, SC_E1 = 39936, SC_E2 = 40448, SC_BUF = 40960;
#ifdef NAIVE_SCAN
__device__ __forceinline__ void scan_job(LAS unsigned char* lds, const Params& p, int job) {
    unsigned char* ws = p.ws;
    const bf16_t* qb = (const bf16_t*)(ws + OFF_Y + Y_Q);
    const bf16_t* vb = (const bf16_t*)(ws + OFF_Y + Y_V);
    unsigned short* lfo = (unsigned short*)(ws + OFF_Y + Y_LFO);
    int seq, head, dir;
    if (job < 64) { seq = 32 + (job >> 3); head = (job >> 1) & 3; dir = job & 1; } else { const int jj = job - 64; seq = jj >> 3; head = (jj >> 1) & 3; dir = jj & 1; }
    const int nch = seq < 32 ? LP / 32 : LS / 32;
    const int rb = seq < 32 ? seq * LP : RP + (seq - 32) * LS;
    const int t = threadIdx.x, dv = t & 127, kq = t >> 7;
    const size_t fcol = (size_t)dir * 512 + head * 128, qcol = (size_t)head * 128;
    LAS float* Fs = (LAS float*)lds; LAS float* Qs = Fs + 4096; LAS float* Vs = Qs + 4096; LAS float* Os = Vs + 4096;
    float S[32];
#pragma unroll
    for (int k = 0; k < 32; ++k) S[k] = 0.f;
    for (int cc = 0; cc < nch; ++cc) {
        const int c = dir ? nch - 1 - cc : cc;
#pragma unroll
        for (int j = 0; j < 8; ++j) { const int idx = j * 512 + t, i = idx >> 7, ch = idx & 127; const size_t r = (size_t)rb + c * 32 + (dir ? 31 - i : i);
            Fs[idx] = h2f(lfo[r * 1024 + fcol + ch]); Qs[idx] = bf2f(qb[r * 512 + qcol + ch]); Vs[idx] = bf2f(vb[r * 512 + qcol + ch]); }
        __syncthreads();
        for (int i = 0; i < 32; ++i) {
            const float v = Vs[i * 128 + dv]; float o = 0.f;
#pragma unroll
            for (int kk = 0; kk < 32; ++kk) { const float f = Fs[i * 128 + kq * 32 + kk]; S[kk] = f * S[kk] + (1.0f - f) * v; o += S[kk] * Qs[i * 128 + kq * 32 + kk]; }
            Os[(kq * 32 + i) * 128 + dv] = o;
        }
        __syncthreads();
#pragma unroll
        for (int j = 0; j < 8; ++j) { const int idx = j * 512 + t, i = idx >> 7, d = idx & 127; const size_t r = (size_t)rb + c * 32 + (dir ? 31 - i : i);
            const float o = (Os[i * 128 + d] + Os[(32 + i) * 128 + d]) + (Os[(64 + i) * 128 + d] + Os[(96 + i) * 128 + d]);
            lfo[r * 1024 + fcol + d] = (unsigned short)(cvt_pk_bf16(o, 0.f) & 0xffff); }
        __syncthreads();
    }
}
#else
__device__ __forceinline__ void scan_job(LAS unsigned char* lds, const Params& p, int job) {
    unsigned char* ws = p.ws;
    const bf16_t* qb = (const bf16_t*)(ws + OFF_Y + Y_Q);
    const bf16_t* vb = (const bf16_t*)(ws + OFF_Y + Y_V);
    unsigned short* lfo = (unsigned short*)(ws + OFF_Y + Y_LFO);
    int seq, head, dir;
    if (job < 64) { seq = 32 + (job >> 3); head = (job >> 1) & 3; dir = job & 1; } else { const int jj = job - 64; seq = jj >> 3; head = (jj >> 1) & 3; dir = jj & 1; }
    const int nch = seq < 32 ? LP / 32 : LS / 32;
    const int rb = seq < 32 ? seq * LP : RP + (seq - 32) * LS;
    const int t = threadIdx.x, lane = t & 63, w = __builtin_amdgcn_readfirstlane(t >> 6), g = lane >> 4, l15 = lane & 15;
    const int ch = t & 127, seg = t >> 7;
    const size_t fcol = (size_t)dir * 512 + head * 128, qcol = (size_t)head * 128;
    f32x4 S[8];
#pragma unroll
    for (int k = 0; k < 8; ++k) S[k] = (f32x4){0.f, 0.f, 0.f, 0.f};
    unsigned short fr_[8], qr_[8], vr_[8];
    { const int c = dir ? nch - 1 : 0;
#pragma unroll
      for (int j = 0; j < 8; ++j) { const int i = seg * 8 + j; const size_t r = (size_t)rb + c * 32 + (dir ? 31 - i : i);
          fr_[j] = lfo[r * 1024 + fcol + ch]; qr_[j] = qb[r * 512 + qcol + ch]; vr_[j] = vb[r * 512 + qcol + ch]; } }
    for (int cc = 0; cc < nch; ++cc) {
        LAS unsigned char* B = lds + (cc & 1) * SC_BUF;
        const int c = dir ? nch - 1 - cc : cc;
        float f[8], P[8];
#pragma unroll
        for (int j = 0; j < 8; ++j) f[j] = h2f(fr_[j]);
        P[0] = f[0];
#pragma unroll
        for (int j = 1; j < 8; ++j) P[j] = P[j - 1] * f[j];
        LAS float* tot = (LAS float*)(B + SC_TOT);
        tot[seg * 128 + ch] = P[7];
        __syncthreads();
        const float t0 = tot[ch], t1 = tot[128 + ch], t2 = tot[256 + ch], t3 = tot[384 + ch];
        const float P15 = t0 * t1, P31 = P15 * t2 * t3;
        const float pre = seg == 0 ? 1.0f : (seg == 1 ? t0 : (seg == 2 ? P15 : P15 * t2));
        const float inv15 = 1.0f / P15;
        const float sc = pre * inv15;
        unsigned short kt8[8];
#pragma unroll
        for (int j = 0; j < 8; ++j) {
            const float E = P[j] * sc, Ri = __builtin_amdgcn_rcpf(E);
            const float qt = bf2f(qr_[j]) * E, kt = (1.0f - f[j]) * Ri;
            const unsigned pk = cvt_pk_bf16(qt, kt);
            const int i = seg * 8 + j;
            *(LAS unsigned short*)(B + SC_QT + i * 272 + ch * 2) = (unsigned short)(pk & 0xffff);
            *(LAS unsigned short*)(B + SC_KT + i * 272 + ch * 2) = (unsigned short)(pk >> 16);
            kt8[j] = (unsigned short)(pk >> 16);
        }
        { u32x4 wk; wk.x = kt8[0] | ((unsigned)kt8[1] << 16); wk.y = kt8[2] | ((unsigned)kt8[3] << 16); wk.z = kt8[4] | ((unsigned)kt8[5] << 16); wk.w = kt8[6] | ((unsigned)kt8[7] << 16);
          *(LAS u32x4*)(B + SC_KTT + ch * 80 + seg * 16) = wk;
          u32x4 wv; wv.x = vr_[0] | ((unsigned)vr_[1] << 16); wv.y = vr_[2] | ((unsigned)vr_[3] << 16); wv.z = vr_[4] | ((unsigned)vr_[5] << 16); wv.w = vr_[6] | ((unsigned)vr_[7] << 16);
          *(LAS u32x4*)(B + SC_VT + ch * 80 + seg * 16) = wv; }
        if (seg == 0) { ((LAS float*)(B + SC_E1))[ch] = P15; ((LAS float*)(B + SC_E2))[ch] = P31 * inv15; }
        if (cc + 1 < nch) { const int c2 = dir ? nch - 2 - cc : cc + 1;
#pragma unroll
            for (int j = 0; j < 8; ++j) { const int i = seg * 8 + j; const size_t r = (size_t)rb + c2 * 32 + (dir ? 31 - i : i);
                fr_[j] = lfo[r * 1024 + fcol + ch]; qr_[j] = qb[r * 512 + qcol + ch]; vr_[j] = vb[r * 512 + qcol + ch]; } }
        __syncthreads();
        bf16x8 Aq[2][4], Ak[2][4];
#pragma unroll
        for (int it = 0; it < 2; ++it)
#pragma unroll
            for (int ks = 0; ks < 4; ++ks) {
                const LAS unsigned char* qa = B + SC_QT + (it * 16 + l15) * 272 + (ks * 32 + g * 4) * 2;
                const LAS unsigned char* ka = B + SC_KT + (it * 16 + l15) * 272 + (ks * 32 + g * 4) * 2;
                const u32x2 q0 = *(const LAS u32x2*)qa, q1 = *(const LAS u32x2*)(qa + 32), k0 = *(const LAS u32x2*)ka, k1 = *(const LAS u32x2*)(ka + 32);
                u32x4 qq = {q0.x, q0.y, q1.x, q1.y}, kk = {k0.x, k0.y, k1.x, k1.y};
                Aq[it][ks] = __builtin_bit_cast(bf16x8, qq); Ak[it][ks] = __builtin_bit_cast(bf16x8, kk);
            }
#pragma unroll
        for (int kt = 0; kt < 8; ++kt) S[kt] *= *(const LAS f32x4*)(B + SC_E1 + (kt * 16 + g * 4) * 4);
        f32x4 o0 = {0.f, 0.f, 0.f, 0.f}, o1 = o0, c00 = o0, c01 = o0, c11 = o0;
#pragma unroll
        for (int ks = 0; ks < 4; ++ks) {
            u32x4 sw; sw.x = cvt_pk_bf16(S[2 * ks][0], S[2 * ks][1]); sw.y = cvt_pk_bf16(S[2 * ks][2], S[2 * ks][3]); sw.z = cvt_pk_bf16(S[2 * ks + 1][0], S[2 * ks + 1][1]); sw.w = cvt_pk_bf16(S[2 * ks + 1][2], S[2 * ks + 1][3]);
            const bf16x8 Sf = __builtin_bit_cast(bf16x8, sw);
            o0 = __builtin_amdgcn_mfma_f32_16x16x32_bf16(Aq[0][ks], Sf, o0, 0, 0, 0);
            o1 = __builtin_amdgcn_mfma_f32_16x16x32_bf16(Aq[1][ks], Sf, o1, 0, 0, 0);
            c00 = __builtin_amdgcn_mfma_f32_16x16x32_bf16(Ak[0][ks], Aq[0][ks], c00, 0, 0, 0);
            c01 = __builtin_amdgcn_mfma_f32_16x16x32_bf16(Ak[0][ks], Aq[1][ks], c01, 0, 0, 0);
            c11 = __builtin_amdgcn_mfma_f32_16x16x32_bf16(Ak[1][ks], Aq[1][ks], c11, 0, 0, 0);
        }
#pragma unroll
        for (int e = 0; e < 4; ++e) { const bool keep = (g * 4 + e) <= l15; c00[e] = keep ? c00[e] : 0.f; c11[e] = keep ? c11[e] : 0.f; }
        { u32x4 pw; pw.x = cvt_pk_bf16(c00[0], c00[1]); pw.y = cvt_pk_bf16(c00[2], c00[3]); pw.z = 0u; pw.w = 0u;
          u32x4 pw1; pw1.x = cvt_pk_bf16(c01[0], c01[1]); pw1.y = cvt_pk_bf16(c01[2], c01[3]); pw1.z = cvt_pk_bf16(c11[0], c11[1]); pw1.w = cvt_pk_bf16(c11[2], c11[3]);
          const LAS unsigned char* va = B + SC_VT + (w * 16 + l15) * 80;
          const u32x2 v0 = *(const LAS u32x2*)(va + g * 8), v1 = *(const LAS u32x2*)(va + 32 + g * 8);
          u32x4 vp = {v0.x, v0.y, v1.x, v1.y};
          const bf16x8 Vp = __builtin_bit_cast(bf16x8, vp);
          o0 = __builtin_amdgcn_mfma_f32_16x16x32_bf16(__builtin_bit_cast(bf16x8, pw), Vp, o0, 0, 0, 0);
          o1 = __builtin_amdgcn_mfma_f32_16x16x32_bf16(__builtin_bit_cast(bf16x8, pw1), Vp, o1, 0, 0, 0);
          const bf16x8 Vn = *(const LAS bf16x8*)(va + g * 16);
#pragma unroll
          for (int kt = 0; kt < 8; ++kt) {
              const bf16x8 Ka = *(const LAS bf16x8*)(B + SC_KTT + (kt * 16 + l15) * 80 + g * 16);
              S[kt] = __builtin_amdgcn_mfma_f32_16x16x32_bf16(Ka, Vn, S[kt], 0, 0, 0);
          }
        }
#pragma unroll
        for (int kt = 0; kt < 8; ++kt) S[kt] *= *(const LAS f32x4*)(B + SC_E2 + (kt * 16 + g * 4) * 4);
#pragma unroll
        for (int e = 0; e < 4; ++e) {
            const int i0 = g * 4 + e, i1 = 16 + g * 4 + e;
            const size_t r0 = (size_t)rb + c * 32 + (dir ? 31 - i0 : i0), r1 = (size_t)rb + c * 32 + (dir ? 31 - i1 : i1);
            lfo[r0 * 1024 + fcol + w * 16 + l15] = (unsigned short)(cvt_pk_bf16(o0[e], 0.f) & 0xffff);
            lfo[r1 * 1024 + fcol + w * 16 + l15] = (unsigned short)(cvt_pk_bf16(o1[e], 0.f) & 0xffff);
        }
    }
    __syncthreads();
}
#endif
__device__ __forceinline__ void phase_scan(LAS unsigned char* lds, const Params& p) {
    const int b = blockIdx.x;
    const bool stdg = gridDim.x == 256;
    for (int it = 0;; ++it) {
        int job;
        if (stdg) { if (it == 0) job = b; else if (it == 1 && b >= 64 && b < 128) job = b + 192; else break; }
        else { job = b + it * (int)gridDim.x; if (job >= 320) break; }
        scan_job(lds, p, job);
    }
}

__device__ __forceinline__ void phase_mix(LAS unsigned char* lds, const Params& p) {
    unsigned char* ws = p.ws;
    const bf16_t* gate = (const bf16_t*)(ws + OFF_Y + Y_Q);
    const bf16_t* glu = (const bf16_t*)(ws + OFF_Y + Y_V);
    bf16_t* mix = (bf16_t*)(ws + OFF_Y + Y_LFO);
    const int t = threadIdx.x, lane = t & 63, w = t >> 6;
    float cw[31];
#pragma unroll
    for (int j = 0; j < 31; ++j) cw[j] = p.in[11][j * 512 + t];
    const float cb = p.in[12][t];
    LAS float* tile = (LAS float*)lds;
    float lg[8], lb_[8], hn[8];
#pragma unroll
    for (int e = 0; e < 8; ++e) { lg[e] = p.in[13][lane * 8 + e]; lb_[e] = p.in[14][lane * 8 + e]; hn[e] = p.in[10][lane * 8 + e]; }
    for (int tix = blockIdx.x; tix < R / 32; tix += gridDim.x) {
        const int r0 = tix * 32;
        float x[62];
#pragma unroll
        for (int i = 0; i < 62; ++i) { const int r = r0 - 15 + i; x[i] = (r >= 0 && r < R) ? bf2f(glu[(size_t)r * 512 + t]) : 0.f; }
#pragma unroll
        for (int i = 0; i < 32; ++i) { float a = cb;
#pragma unroll
            for (int j = 0; j < 31; ++j) a += cw[j] * x[i + j];
            tile[i * 512 + t] = a; }
        __syncthreads();
#pragma unroll
        for (int rr = 0; rr < 4; ++rr) {
            const int i = w * 4 + rr; const size_t r = (size_t)r0 + i;
            { const u32x4 a = *(const u32x4*)(mix + r * 1024 + lane * 8), b = *(const u32x4*)(mix + r * 1024 + 512 + lane * 8), gt = *(const u32x4*)(gate + r * 512 + lane * 8);
              float o[8] = {bflo(a.x) + bflo(b.x), bfhi(a.x) + bfhi(b.x), bflo(a.y) + bflo(b.y), bfhi(a.y) + bfhi(b.y), bflo(a.z) + bflo(b.z), bfhi(a.z) + bfhi(b.z), bflo(a.w) + bflo(b.w), bfhi(a.w) + bfhi(b.w)};
              const float gg[8] = {bflo(gt.x), bfhi(gt.x), bflo(gt.y), bfhi(gt.y), bflo(gt.z), bfhi(gt.z), bflo(gt.w), bfhi(gt.w)};
              float sq = 0.f;
#pragma unroll
              for (int e = 0; e < 8; ++e) sq += o[e] * o[e];
              sq += __shfl_xor(sq, 1); sq += __shfl_xor(sq, 2); sq += __shfl_xor(sq, 4); sq += __shfl_xor(sq, 8);
              const float rs = __builtin_amdgcn_rsqf(sq * (1.0f / 128.0f) + RMS_EPS);
#pragma unroll
              for (int e = 0; e < 8; ++e) o[e] = o[e] * rs * hn[e] * gg[e];
              u32x4 wv; wv.x = cvt_pk_bf16(o[0], o[1]); wv.y = cvt_pk_bf16(o[2], o[3]); wv.z = cvt_pk_bf16(o[4], o[5]); wv.w = cvt_pk_bf16(o[6], o[7]);
              *(u32x4*)(mix + r * 1024 + lane * 8) = wv; }
            { const f32x4 y0 = *(const LAS f32x4*)(tile + i * 512 + lane * 8), y1 = *(const LAS f32x4*)(tile + i * 512 + lane * 8 + 4);
              float y[8] = {y0[0], y0[1], y0[2], y0[3], y1[0], y1[1], y1[2], y1[3]};
              float s = 0.f;
#pragma unroll
              for (int e = 0; e < 8; ++e) s += y[e];
#pragma unroll
              for (int o = 32; o >= 1; o >>= 1) s += __shfl_xor(s, o);
              const float mu = s * (1.0f / 512.0f); float q = 0.f;
#pragma unroll
              for (int e = 0; e < 8; ++e) { y[e] -= mu; q += y[e] * y[e]; }
#pragma unroll
              for (int o = 32; o >= 1; o >>= 1) q += __shfl_xor(q, o);
              const float rs = __builtin_amdgcn_rsqf(q * (1.0f / 512.0f) + LN_EPS);
#pragma unroll
              for (int e = 0; e < 8; ++e) y[e] = siluf_(y[e] * rs * lg[e] + lb_[e]);
              u32x4 wv; wv.x = cvt_pk_bf16(y[0], y[1]); wv.y = cvt_pk_bf16(y[2], y[3]); wv.z = cvt_pk_bf16(y[4], y[5]); wv.w = cvt_pk_bf16(y[6], y[7]);
              *(u32x4*)(mix + r * 1024 + 512 + lane * 8) = wv; }
        }
        __syncthreads();
    }
}

__device__ __forceinline__ void phase_final(const Params& p) {
    const float* ss3 = (const float*)(p.ws + OFF_SS) + 3 * (size_t)R;
    const int wave = threadIdx.x >> 6, lane = threadIdx.x & 63;
    f32x4 g[4];
#pragma unroll
    for (int j = 0; j < 4; ++j) g[j] = *(const f32x4*)(p.in[20] + j * 256 + lane * 4);
    for (int r = blockIdx.x * 8 + wave; r < R; r += gridDim.x * 8) {
        int seq, pos; row_info(r, seq, pos);
        if (pos < 32) continue;
        float* op = p.out + ((long)r - 32 * (seq + 1)) * 1024;
        const float s = __builtin_amdgcn_rsqf(ss3[r] * (1.0f / 1024.0f) + RMS_EPS);
#pragma unroll
        for (int j = 0; j < 4; ++j) { f32x4 v = *(const f32x4*)(op + j * 256 + lane * 4); v = v * s * g[j]; *(f32x4*)(op + j * 256 + lane * 4) = v; }
    }
}

__global__ void __launch_bounds__(NTHREADS, 2) hymba_fwd(Params p) {
    extern __shared__ __attribute__((aligned(16))) unsigned char lds_raw[];
    LAS unsigned char* lds = (LAS unsigned char*)lds_raw;
    unsigned char* ws = p.ws;
    float* ss = (float*)(ws + OFF_SS);
    bf16_t* hb = (bf16_t*)(ws + OFF_X);
    bf16_t* Y = (bf16_t*)(ws + OFF_Y);
    const int lo = p.ph_lo, hi = p.ph_hi;
#define IN(k) (lo <= (k) && (k) < hi)
#if COOP
#define SEAM(k) do { if (IN(k) && IN((k) + 1)) { asm volatile("s_waitcnt vmcnt(0) lgkmcnt(0)" ::: "memory"); __syncthreads(); cg::this_grid().sync(); } } while (0)
#else
#define SEAM(k) do { } while (0)
#endif
    #ifndef SKIP_PREP
    if (IN(0)) phase_prep(lds, p);
#endif
    SEAM(0);
    if (IN(1)) { EpiPair<0> E{Y, FF, 0, ss}; pg8::gemm_phase(lds, hb, (const bf16_t*)(ws + OFF_W1), R, 5632, 1024, E); }
    SEAM(1);
    if (IN(2)) { EpiRes<0> E{p.in[0], p.in[1], p.in[2], p.out, hb, ss + R}; pg8::gemm_phase(lds, Y, (const bf16_t*)(ws + OFF_W2), R, 1024, FF, E); }
    SEAM(2);
    if (IN(3)) { EpiZa E{(bf16_t*)(ws + OFF_Y + Y_Q), (bf16_t*)(ws + OFF_Y + Y_V), (unsigned short*)(ws + OFF_Y + Y_LFO), ss + R, (const float*)(ws + OFF_LB)};
        pg8::gemm_phase(lds, hb, (const bf16_t*)(ws + OFF_W3A), R, 2048, 1024, E); }
    SEAM(3);
    #ifndef SKIP_SCAN
    if (IN(4)) phase_scan(lds, p);
#endif
    SEAM(4);
    if (IN(5)) { EpiZb E{(bf16_t*)(ws + OFF_Y + Y_Q), (bf16_t*)(ws + OFF_Y + Y_V), ss + R}; pg8::gemm_phase(lds, hb, (const bf16_t*)(ws + OFF_W3B), R, 1536, 1024, E); }
    SEAM(5);
    #ifndef SKIP_MIX
    if (IN(6)) phase_mix(lds, p);
#endif
    SEAM(6);
    if (IN(7)) { EpiRes<1> E{p.in[0], p.in[1], p.in[2], p.out, hb, ss + 2 * R}; pg8::gemm_phase(lds, (const bf16_t*)(ws + OFF_Y + Y_LFO), (const bf16_t*)(ws + OFF_W4), R, 1024, 1024, E); }
    SEAM(7);
    if (IN(8)) { EpiPair<0> E{Y, FF, 0, ss + 2 * R}; pg8::gemm_phase(lds, hb, (const bf16_t*)(ws + OFF_W5), R, 5632, 1024, E); }
    SEAM(8);
    if (IN(9)) { EpiRes<2> E{p.in[0], p.in[1], p.in[2], p.out, hb, ss + 3 * R}; pg8::gemm_phase(lds, Y, (const bf16_t*)(ws + OFF_W6), R, 1024, FF, E); }
    SEAM(9);
    if (IN(10)) phase_final(p);
#undef IN
#undef SEAM
}

extern "C" void kernel_launch(void* const* d_in, const int* in_sizes, int n_in, void* d_out, int out_size, void* d_ws, size_t ws_size, hipStream_t stream) {
    constexpr int LDS_BYTES = 131072;
    static int grid = 0;
    if (grid == 0) {
        if (n_in != 21 || ws_size < WS_END) { fprintf(stderr, "kernel_launch: need 21 inputs and %zu bytes of workspace; got %d, %zu\n", (size_t)WS_END, n_in, ws_size); grid = -1; return; }
        int dev = 0, cus = 0, per_cu = 0;
        (void)hipGetDevice(&dev); (void)hipDeviceGetAttribute(&cus, hipDeviceAttributeMultiprocessorCount, dev);
        if (hipFuncSetAttribute((const void*)hymba_fwd, hipFuncAttributeMaxDynamicSharedMemorySize, LDS_BYTES) != hipSuccess) { fprintf(stderr, "kernel_launch: hipFuncSetAttribute failed\n"); grid = -1; return; }
        if (hipOccupancyMaxActiveBlocksPerMultiprocessor(&per_cu, (const void*)hymba_fwd, NTHREADS, LDS_BYTES) != hipSuccess || per_cu < 1) per_cu = 1;
        (void)hipGetLastError();
        grid = cus * 1;
        if (grid <= 0) grid = 256;
    }
    if (grid < 0) return;
    Params p{};
    for (int i = 0; i < 21; ++i) p.in[i] = (const float*)d_in[i];
    p.out = (float*)d_out; p.ws = (unsigned char*)d_ws;
#if COOP
    p.ph_lo = 0; p.ph_hi = 11;
    void* args[] = {&p};
    hipError_t e = hipLaunchCooperativeKernel((const void*)hymba_fwd, dim3(grid), dim3(NTHREADS), args, LDS_BYTES, stream);
    if (e != hipSuccess) fprintf(stderr, "cooperative launch failed: %s (grid %d)\n", hipGetErrorString(e), grid);
#else
    for (int ph = 0; ph < 11; ++ph) { p.ph_lo = ph; p.ph_hi = ph + 1; hipLaunchKernelGGL(hymba_fwd, dim3(grid), dim3(NTHREADS), LDS_BYTES, stream, p); }
#endif
}
```

```cpp
#include <hip/hip_runtime.h>
#include <hip/hip_cooperative_groups.h>
#include <cstdio>
namespace cg = cooperative_groups;

#define LAS __attribute__((address_space(3)))
typedef unsigned short bf16_t;
typedef short bf16x8 __attribute__((ext_vector_type(8)));
typedef float f32x4 __attribute__((ext_vector_type(4)));
typedef unsigned u32x4 __attribute__((ext_vector_type(4)));
typedef unsigned u32x2 __attribute__((ext_vector_type(2)));

#ifndef COOP
#define COOP 1
#endif

constexpr int D = 1024, FF = 2816;
constexpr int LP = 2080, LS = 8224;
constexpr int RP = 32 * LP;
constexpr int R = RP + 8 * LS;
constexpr int NTHREADS = 512;
constexpr float RMS_EPS = 1e-6f, LN_EPS = 1e-5f;

constexpr size_t SZ_W1 = (size_t)5632 * 1024 * 2, SZ_W2 = (size_t)1024 * 2816 * 2, SZ_W3A = (size_t)2048 * 1024 * 2, SZ_W3B = (size_t)1536 * 1024 * 2, SZ_W4 = (size_t)1024 * 1024 * 2;
constexpr size_t OFF_W1 = 0, OFF_W2 = OFF_W1 + SZ_W1, OFF_W3A = OFF_W2 + SZ_W2, OFF_W3B = OFF_W3A + SZ_W3A, OFF_W4 = OFF_W3B + SZ_W3B, OFF_W5 = OFF_W4 + SZ_W4, OFF_W6 = OFF_W5 + SZ_W1;
constexpr size_t OFF_SS = OFF_W6 + SZ_W2;
constexpr size_t OFF_LB = OFF_SS + (size_t)4 * R * 4;
constexpr size_t OFF_X = OFF_LB + 4096;
constexpr size_t OFF_Y = OFF_X + (size_t)R * 1024 * 2;
constexpr size_t WS_END = OFF_Y + (size_t)R * 2816 * 2;
constexpr size_t Y_Q = 0, Y_V = (size_t)R * 1024, Y_LFO = (size_t)2 * R * 1024;

struct Params { const float* in[21]; float* out; unsigned char* ws; int ph_lo, ph_hi; };

typedef __bf16 bf16v2_t __attribute__((ext_vector_type(2)));
typedef float f32x2_t __attribute__((ext_vector_type(2)));
__device__ __forceinline__ unsigned cvt_pk_bf16(float lo, float hi) { const f32x2_t v = {lo, hi}; const bf16v2_t b = __builtin_convertvector(v, bf16v2_t); return __builtin_bit_cast(unsigned, b); }
__device__ __forceinline__ float bf2f(unsigned short b) { return __uint_as_float(((unsigned)b) << 16); }
__device__ __forceinline__ float bflo(unsigned w) { return __uint_as_float(w << 16); }
__device__ __forceinline__ float bfhi(unsigned w) { return __uint_as_float(w & 0xffff0000u); }
__device__ __forceinline__ unsigned short f2h(float f) { return __builtin_bit_cast(unsigned short, (_Float16)f); }
__device__ __forceinline__ float h2f(unsigned short h) { return (float)__builtin_bit_cast(_Float16, h); }
__device__ __forceinline__ float sigmoidf_(float x) { return __builtin_amdgcn_rcpf(1.0f + __expf(-x)); }
__device__ __forceinline__ float siluf_(float x) { return x * sigmoidf_(x); }
__device__ __forceinline__ void row_info(int r, int& seq, int& pos) {
    if (r < RP) { seq = r / LP; pos = r - seq * LP; } else { const int q = (r - RP) / LS; seq = 32 + q; pos = (r - RP) - q * LS; }
}

namespace pg8 {
constexpr int BM = 256, BK = 64, HALF = 128, HTB = HALF * BK * 2, STAGE_BYTES = 8 * HTB, NXCD = 8, WGM = 8;
__host__ __device__ __forceinline__ int lds_byte(int r, int c) { const int st = (r >> 4) * 2 + (c >> 5), rr = r & 15, cc = c & 31, ob = rr * 64 + cc * 2; return st * 1024 + (ob ^ (((ob >> 9) & 1) << 5)); }
__host__ __device__ __forceinline__ void stage_rc(int b, int& Rr, int& C) { const int st = b / 1024, sb = b % 1024, swz = sb ^ (((sb >> 9) & 1) << 5); Rr = (st >> 1) * 16 + swz / 64; C = (st & 1) * 32 + (swz % 64) / 2; }
__host__ __device__ __forceinline__ int perm32(int rho) { const int n = rho >> 4, i = rho & 15; return 8 * (i >> 2) + 4 * n + (i & 3); }
struct Unit { int pm, pn; };
struct StaticOrder {
    int nM, nN, nwg, G, c;
    __device__ void init(int M, int N, int G_, int c_) { nM = M / BM; nN = N / BM; nwg = nM * nN; G = G_; c = c_; }
    __device__ bool next(int i, Unit& u) const {
        const long L = (long)i * G + c; if (L >= nwg) return false;
        int wgid = (int)L; { const int q = nwg / NXCD, r = nwg % NXCD, xcd = wgid % NXCD, off = wgid / NXCD; wgid = (xcd < r ? xcd * (q + 1) : r * (q + 1) + (xcd - r) * q) + off; }
        const int nig = WGM * nN, gid = wgid / nig, fm = gid * WGM, gsz = (nM - fm) < WGM ? (nM - fm) : WGM;
        u.pm = fm + ((wgid % nig) % gsz); u.pn = (wgid % nig) / gsz; return true;
    }
};
template <class Epi>
__device__ __forceinline__ void gemm_phase(LAS unsigned char* lds, const bf16_t* A, const bf16_t* Bt, int M, int N, int K, const Epi& E) {
    const int tid = threadIdx.x, wid = __builtin_amdgcn_readfirstlane(tid >> 6), lane = tid & 63, wr = wid >> 2, wc = wid & 3, fr = lane & 15, fq = lane >> 4;
    const int nt = K / BK;
    StaticOrder S; S.init(M, N, (int)gridDim.x, (int)blockIdx.x);
    unsigned voffA[2], voffB[2];
#pragma unroll
    for (int i = 0; i < 2; ++i) { int Rr, C; stage_rc(tid * 16 + i * 8192, Rr, C); const int Rb = (Rr & ~31) + perm32(Rr & 31);
        voffA[i] = (unsigned)(Rr * K + C) * 2u; voffB[i] = (unsigned)(Rb * K + C) * 2u; }
    const size_t kstep = (size_t)(BK * 2);
    const size_t hstep = (size_t)HALF * K * 2;
    const size_t tstep = 2 * hstep;
    const unsigned ldsw = (unsigned)wid * 1024u;
    const int aoff = lds_byte(wr * 64 + fr, fq * 8), boff = lds_byte(wc * 32 + fr, fq * 8);
#define PG8_SA(b, h) (((b) * 2 + (h)) * HTB)
#define PG8_SB(b, h) ((4 + (b) * 2 + (h)) * HTB)
#define PG8_STAGE(bufoff, gbase, voff) do { _Pragma("unroll") for (int _i = 0; _i < 2; ++_i) \
        __builtin_amdgcn_global_load_lds((const unsigned*)((const char*)(gbase) + (voff)[_i]), (LAS unsigned*)(lds + (bufoff) + ldsw + _i * 8192), 16, 0, 0); } while (0)
#define PG8_LDA(dst, b, h) do { _Pragma("unroll") for (int m = 0; m < 4; ++m) _Pragma("unroll") for (int k = 0; k < 2; ++k) dst[m][k] = *(const LAS bf16x8*)(lds + PG8_SA(b, h) + aoff + m * 2048 + k * 1024); } while (0)
#define PG8_LDB(dst, b, h) do { _Pragma("unroll") for (int n = 0; n < 2; ++n) _Pragma("unroll") for (int k = 0; k < 2; ++k) dst[n][k] = *(const LAS bf16x8*)(lds + PG8_SB(b, h) + boff + n * 2048 + k * 1024); } while (0)
#define PG8_MMA(ai, bj, At, Bt_) do { __builtin_amdgcn_s_setprio(1); _Pragma("unroll") for (int m = 0; m < 4; ++m) _Pragma("unroll") for (int n = 0; n < 2; ++n) _Pragma("unroll") for (int k = 0; k < 2; ++k) \
        acc[ai][bj][m][n] = __builtin_amdgcn_mfma_f32_16x16x32_bf16(Bt_[n][k], At[m][k], acc[ai][bj][m][n], 0, 0, 0); __builtin_amdgcn_s_setprio(0); } while (0)
#define PG8_WAIT_V(n) asm volatile("s_waitcnt vmcnt(" #n ")" ::: "memory")
#define PG8_WAIT_L(n) asm volatile("s_waitcnt lgkmcnt(" #n ")" ::: "memory")
#define PG8_BAR __builtin_amdgcn_s_barrier()
#define PG8_SCHED __builtin_amdgcn_sched_barrier(0)
    Unit cur, nxt; int ui = 0;
    if (!S.next(0, cur)) return;
    f32x4 acc[2][2][4][2];
#pragma unroll
    for (int a = 0; a < 2; ++a)
#pragma unroll
        for (int b = 0; b < 2; ++b)
#pragma unroll
            for (int m = 0; m < 4; ++m)
#pragma unroll
                for (int n = 0; n < 2; ++n) acc[a][b][m][n] = (f32x4){0.f, 0.f, 0.f, 0.f};
    bf16x8 At[4][2], B0[2][2], B1[2][2];
    const char* cA = (const char*)A + (size_t)cur.pm * tstep; const char* cB = (const char*)Bt + (size_t)cur.pn * tstep;
    PG8_STAGE(PG8_SB(0, 0), cB, voffB); PG8_STAGE(PG8_SA(0, 0), cA, voffA); PG8_STAGE(PG8_SB(0, 1), cB + hstep, voffB); PG8_STAGE(PG8_SA(0, 1), cA + hstep, voffA);
    if (wr == 1) PG8_BAR;
    PG8_WAIT_V(4); PG8_BAR;
    PG8_STAGE(PG8_SB(1, 0), cB + kstep, voffB); PG8_STAGE(PG8_SA(1, 0), cA + kstep, voffA); PG8_STAGE(PG8_SB(1, 1), cB + hstep + kstep, voffB);
    PG8_WAIT_V(6); PG8_BAR;
    for (;;) {
        const bool has_next = S.next(ui + 1, nxt);
        const char* nA = has_next ? (const char*)A + (size_t)nxt.pm * tstep : cA; const char* nB = has_next ? (const char*)Bt + (size_t)nxt.pn * tstep : cB;
        for (int t = 0; t < nt; t += 2) {
            const bool last = (t == nt - 2);
            const char* a1 = cA + (size_t)(t + 1) * kstep;
            const char* a2 = last ? nA : cA + (size_t)(t + 2) * kstep; const char* b2 = last ? nB : cB + (size_t)(t + 2) * kstep;
            const char* a3 = a2 + kstep; const char* b3 = b2 + kstep;
            PG8_LDB(B0, 0, 0); PG8_SCHED; PG8_LDA(At, 0, 0); PG8_STAGE(PG8_SA(1, 1), a1 + hstep, voffA);
            PG8_WAIT_L(8); PG8_BAR; PG8_WAIT_L(0); PG8_MMA(0, 0, At, B0); PG8_BAR; PG8_SCHED;
            PG8_LDB(B1, 0, 1); PG8_STAGE(PG8_SB(0, 0), b2, voffB);
            PG8_BAR; PG8_WAIT_L(0); PG8_MMA(0, 1, At, B1); PG8_BAR;
            PG8_LDA(At, 0, 1); PG8_STAGE(PG8_SA(0, 0), a2, voffA);
            PG8_BAR; PG8_WAIT_L(0); PG8_MMA(1, 0, At, B0); PG8_BAR; PG8_SCHED;
            PG8_STAGE(PG8_SB(0, 1), b2 + hstep, voffB);
            PG8_WAIT_V(6); PG8_BAR; PG8_MMA(1, 1, At, B1); PG8_BAR;
            PG8_LDB(B0, 1, 0); PG8_SCHED; PG8_LDA(At, 1, 0); PG8_STAGE(PG8_SA(0, 1), a2 + hstep, voffA);
            PG8_WAIT_L(8); PG8_BAR; PG8_WAIT_L(0); PG8_MMA(0, 0, At, B0); PG8_BAR; PG8_SCHED;
            PG8_LDB(B1, 1, 1); PG8_STAGE(PG8_SB(1, 0), b3, voffB);
            PG8_BAR; PG8_WAIT_L(0); PG8_MMA(0, 1, At, B1); PG8_BAR;
            PG8_LDA(At, 1, 1); PG8_STAGE(PG8_SA(1, 0), a3, voffA);
            PG8_BAR; PG8_WAIT_L(0); PG8_MMA(1, 0, At, B0); PG8_BAR; PG8_SCHED;
            PG8_STAGE(PG8_SB(1, 1), b3 + hstep, voffB);
            PG8_WAIT_V(6); PG8_BAR; PG8_MMA(1, 1, At, B1); PG8_BAR;
        }
        E(acc, cur, wr, wc, fr, fq);
        if (!has_next) break;
#pragma unroll
        for (int a = 0; a < 2; ++a)
#pragma unroll
            for (int b = 0; b < 2; ++b)
#pragma unroll
                for (int m = 0; m < 4; ++m)
#pragma unroll
                    for (int n = 0; n < 2; ++n) acc[a][b][m][n] = (f32x4){0.f, 0.f, 0.f, 0.f};
        cur = nxt; cA = nA; cB = nB; ++ui;
    }
    PG8_WAIT_V(0);
    if (wr == 0) PG8_BAR;
    PG8_BAR;
#undef PG8_SA
#undef PG8_SB
#undef PG8_STAGE
#undef PG8_LDA
#undef PG8_LDB
#undef PG8_MMA
#undef PG8_WAIT_V
#undef PG8_WAIT_L
#undef PG8_BAR
#undef PG8_SCHED
}
}
using pg8::Unit;
typedef f32x4 Acc[2][2][4][2];

template <int MODE> struct EpiPair {
    bf16_t* O; int ldo; int pn0; const float* ss;
    __device__ __forceinline__ void operator()(const Acc& acc, const Unit& u, int wr, int wc, int fr, int fq) const {
        const int col = (u.pn - pn0) * 128 + wc * 32 + fq * 8;
#pragma unroll
        for (int ai = 0; ai < 2; ++ai)
#pragma unroll
            for (int m = 0; m < 4; ++m) {
                const int r = u.pm * 256 + ai * 128 + wr * 64 + m * 16 + fr;
                const float s = __builtin_amdgcn_rsqf(ss[r] * (1.0f / 1024.0f) + RMS_EPS);
                float o[8];
#pragma unroll
                for (int n = 0; n < 2; ++n)
#pragma unroll
                    for (int j = 0; j < 4; ++j) { const float a = acc[ai][0][m][n][j] * s, b = acc[ai][1][m][n][j] * s; o[n * 4 + j] = MODE == 0 ? siluf_(a) * b : a * sigmoidf_(b); }
                u32x4 w; w.x = cvt_pk_bf16(o[0], o[1]); w.y = cvt_pk_bf16(o[2], o[3]); w.z = cvt_pk_bf16(o[4], o[5]); w.w = cvt_pk_bf16(o[6], o[7]);
                *(u32x4*)(O + (size_t)r * ldo + col) = w;
            }
    }
};
template <int MODE> struct EpiRes {
    const float* xp; const float* xs; const float* meta; float* out; bf16_t* hb; float* ss;
    __device__ __forceinline__ void operator()(const Acc& acc, const Unit& u, int wr, int wc, int fr, int fq) const {
        const int col0 = u.pn * 256 + wc * 32 + fq * 8;
        const float sc = (MODE == 1) ? 1.0f : 0.5f;
#pragma unroll
        for (int ai = 0; ai < 2; ++ai)
#pragma unroll
            for (int m = 0; m < 4; ++m) {
                const int r = u.pm * 256 + ai * 128 + wr * 64 + m * 16 + fr;
                int seq, pos; row_info(r, seq, pos);
                const bool real = pos >= 32;
                const long orow = (long)r - 32 * (seq + 1);
                float* op = out + orow * 1024 + col0;
                const float* src;
                if (MODE == 0) src = real ? ((orow < 65536 ? xp + orow * 1024 : xs + (orow - 65536) * 1024) + col0) : meta + (size_t)((pos - 16) & 15) * 1024 + col0;
                else src = op;
                const bool have = (MODE == 0) ? (pos >= 16) : real;
                float sq = 0.f;
#pragma unroll
                for (int bj = 0; bj < 2; ++bj) {
                    f32x4 h0 = {0.f, 0.f, 0.f, 0.f}, h1 = {0.f, 0.f, 0.f, 0.f};
                    if (have) { h0 = *(const f32x4*)(src + bj * 128); h1 = *(const f32x4*)(src + bj * 128 + 4); }
                    f32x4 v0 = h0 + acc[ai][bj][m][0] * sc, v1 = h1 + acc[ai][bj][m][1] * sc;
                    if (MODE != 0 && !real) { v0 = (f32x4){0.f, 0.f, 0.f, 0.f}; v1 = v0; }
                    if (real) { *(f32x4*)(op + bj * 128) = v0; *(f32x4*)(op + bj * 128 + 4) = v1; }
                    if (MODE != 2) { u32x4 w; w.x = cvt_pk_bf16(v0[0], v0[1]); w.y = cvt_pk_bf16(v0[2], v0[3]); w.z = cvt_pk_bf16(v1[0], v1[1]); w.w = cvt_pk_bf16(v1[2], v1[3]);
                        *(u32x4*)(hb + (size_t)r * 1024 + col0 + bj * 128) = w; }
                    sq += (v0[0] * v0[0] + v0[1] * v0[1]) + (v0[2] * v0[2] + v0[3] * v0[3]) + (v1[0] * v1[0] + v1[1] * v1[1]) + (v1[2] * v1[2] + v1[3] * v1[3]);
                }
                sq += __shfl_xor(sq, 16); sq += __shfl_xor(sq, 32);
                if (fq == 0 && (MODE != 2 || real)) atomicAdd(ss + r, sq);
            }
    }
};
struct EpiZa {
    bf16_t* q; bf16_t* v; unsigned short* lfo; const float* ss; const float* lbv;
    __device__ __forceinline__ void operator()(const Acc& acc, const Unit& u, int wr, int wc, int fr, int fq) const {
        const int cw = wc * 32 + fq * 8;
        const int kind = u.pn < 2 ? 0 : (u.pn < 6 ? 1 : 2);
#pragma unroll
        for (int ai = 0; ai < 2; ++ai)
#pragma unroll
            for (int m = 0; m < 4; ++m) {
                const int r = u.pm * 256 + ai * 128 + wr * 64 + m * 16 + fr;
                const float s = __builtin_amdgcn_rsqf(ss[r] * (1.0f / 1024.0f) + RMS_EPS);
                int seq, pos; row_info(r, seq, pos);
#pragma unroll
                for (int bj = 0; bj < 2; ++bj) {
                    float z[8];
#pragma unroll
                    for (int n = 0; n < 2; ++n)
#pragma unroll
                        for (int j = 0; j < 4; ++j) z[n * 4 + j] = acc[ai][bj][m][n][j] * s;
                    u32x4 w;
                    if (kind == 0) {
#pragma unroll
                        for (int e = 0; e < 8; ++e) z[e] = siluf_(z[e]);
                        w.x = cvt_pk_bf16(z[0], z[1]); w.y = cvt_pk_bf16(z[2], z[3]); w.z = cvt_pk_bf16(z[4], z[5]); w.w = cvt_pk_bf16(z[6], z[7]);
                        *(u32x4*)(q + (size_t)r * 512 + u.pn * 256 + bj * 128 + cw) = w;
                    } else if (kind == 1) {
                        const int c = (u.pn - 2) * 256 + bj * 128 + cw;
                        const f32x4 l0 = *(const f32x4*)(lbv + c), l1 = *(const f32x4*)(lbv + c + 4);
                        unsigned short hh[8];
#pragma unroll
                        for (int e = 0; e < 8; ++e) { const float lb = e < 4 ? l0[e & 3] : l1[e & 3]; float f = lb + (1.0f - lb) * sigmoidf_(z[e]); if (pos < 16) f = 1.0f; hh[e] = f2h(f); }
                        w.x = hh[0] | ((unsigned)hh[1] << 16); w.y = hh[2] | ((unsigned)hh[3] << 16); w.z = hh[4] | ((unsigned)hh[5] << 16); w.w = hh[6] | ((unsigned)hh[7] << 16);
                        *(u32x4*)(lfo + (size_t)r * 1024 + c) = w;
                    } else {
                        w.x = cvt_pk_bf16(z[0], z[1]); w.y = cvt_pk_bf16(z[2], z[3]); w.z = cvt_pk_bf16(z[4], z[5]); w.w = cvt_pk_bf16(z[6], z[7]);
                        *(u32x4*)(v + (size_t)r * 512 + (u.pn - 6) * 256 + bj * 128 + cw) = w;
                    }
                }
            }
    }
};
struct EpiZb {
    bf16_t* gate; bf16_t* glu; const float* ss;
    __device__ __forceinline__ void operator()(const Acc& acc, const Unit& u, int wr, int wc, int fr, int fq) const {
        if (u.pn >= 2) { EpiPair<1> e{glu, 512, 2, ss}; e(acc, u, wr, wc, fr, fq); return; }
        const int cw = wc * 32 + fq * 8;
#pragma unroll
        for (int ai = 0; ai < 2; ++ai)
#pragma unroll
            for (int m = 0; m < 4; ++m) {
                const int r = u.pm * 256 + ai * 128 + wr * 64 + m * 16 + fr;
                const float s = __builtin_amdgcn_rsqf(ss[r] * (1.0f / 1024.0f) + RMS_EPS);
#pragma unroll
                for (int bj = 0; bj < 2; ++bj) {
                    float z[8];
#pragma unroll
                    for (int n = 0; n < 2; ++n)
#pragma unroll
                        for (int j = 0; j < 4; ++j) z[n * 4 + j] = siluf_(acc[ai][bj][m][n][j] * s);
                    u32x4 w; w.x = cvt_pk_bf16(z[0], z[1]); w.y = cvt_pk_bf16(z[2], z[3]); w.z = cvt_pk_bf16(z[4], z[5]); w.w = cvt_pk_bf16(z[6], z[7]);
                    *(u32x4*)(gate + (size_t)r * 512 + u.pn * 256 + bj * 128 + cw) = w;
                }
            }
    }
};

__device__ __forceinline__ void cvt_tile(LAS float* tile, const float* s0, const float* s1, int ld, int mode, const float* gain, bf16_t* dst, int K, int kt, int ntile) {
    const int t = threadIdx.x;
    const int n0 = ntile * 64, k0 = kt * 64;
    const float* src; int col0;
    if (mode == 0) { src = s0; col0 = n0; } else { const int pn = n0 >> 8, w = n0 & 255; src = w < 128 ? s0 : s1; col0 = pn * 128 + (w & 127); }
#pragma unroll
    for (int p = 0; p < 2; ++p) {
        const int kk = (t >> 4) + p * 32, c4 = (t & 15) * 4;
        f32x4 v = *(const f32x4*)(src + (size_t)(k0 + kk) * ld + col0 + c4);
        const float g = gain ? gain[k0 + kk] : 1.0f;
#pragma unroll
        for (int e = 0; e < 4; ++e) tile[kk * 65 + c4 + e] = v[e] * g;
    }
    __syncthreads();
    { const int n = t >> 3, k8 = (t & 7) * 8; float x[8];
#pragma unroll
      for (int j = 0; j < 8; ++j) x[j] = tile[(k8 + j) * 65 + n];
      u32x4 w; w.x = cvt_pk_bf16(x[0], x[1]); w.y = cvt_pk_bf16(x[2], x[3]); w.z = cvt_pk_bf16(x[4], x[5]); w.w = cvt_pk_bf16(x[6], x[7]);
      *(u32x4*)(dst + (size_t)(n0 + n) * K + k0 + k8) = w; }
    __syncthreads();
}
__device__ __forceinline__ void phase_prep(LAS unsigned char* lds, const Params& p) {
    unsigned char* ws = p.ws;
    LAS float* tile = (LAS float*)lds;
    const int J1 = 16 * 88, J2 = 44 * 16, J3A = 16 * 32, J3B = 16 * 24, J4 = 16 * 16;
    const int total = J1 + J2 + J3A + J3B + J4 + J1 + J2;
    for (int job = blockIdx.x; job < total; job += gridDim.x) {
        int j = job;
        const float* s0; const float* s1 = nullptr; const float* gain = nullptr; int ld, mode = 0, K, kt, nt_; bf16_t* dst;
        if (j < J1) { s0 = p.in[4]; s1 = p.in[5]; ld = FF; mode = 1; gain = p.in[3]; dst = (bf16_t*)(ws + OFF_W1); K = 1024; kt = j % 16; nt_ = j / 16; }
        else if ((j -= J1) < J2) { s0 = p.in[6]; ld = 1024; dst = (bf16_t*)(ws + OFF_W2); K = FF; kt = j % 44; nt_ = j / 44; }
        else if ((j -= J2) < J3A) { s0 = p.in[8]; ld = 3584; gain = p.in[7]; dst = (bf16_t*)(ws + OFF_W3A); K = 1024; kt = j % 16; nt_ = j / 16; }
        else if ((j -= J3A) < J3B) { ld = 3584; gain = p.in[7]; K = 1024; kt = j % 16; nt_ = j / 16;
            if (nt_ < 8) { s0 = p.in[8] + 2048; dst = (bf16_t*)(ws + OFF_W3B); }
            else { s0 = p.in[8] + 2560; s1 = p.in[8] + 3072; mode = 1; dst = (bf16_t*)(ws + OFF_W3B) + (size_t)512 * 1024; nt_ -= 8; } }
        else if ((j -= J3B) < J4) { s0 = p.in[15]; ld = 1024; dst = (bf16_t*)(ws + OFF_W4); K = 1024; kt = j % 16; nt_ = j / 16; }
        else if ((j -= J4) < J1) { s0 = p.in[17]; s1 = p.in[18]; ld = FF; mode = 1; gain = p.in[16]; dst = (bf16_t*)(ws + OFF_W5); K = 1024; kt = j % 16; nt_ = j / 16; }
        else { j -= J1; s0 = p.in[19]; ld = 1024; dst = (bf16_t*)(ws + OFF_W6); K = FF; kt = j % 44; nt_ = j / 44; }
        cvt_tile(tile, s0, s1, ld, mode, gain, dst, K, kt, nt_);
    }
    if (blockIdx.x == 0) for (int i = threadIdx.x; i < 1024; i += NTHREADS) { const float l0 = p.in[9][i], l1 = p.in[9][1024 + i]; ((float*)(ws + OFF_LB))[i] = 1.0f / (1.0f + __expf(l1 - l0)); }
    float* ss = (float*)(ws + OFF_SS);
    bf16_t* hb = (bf16_t*)(ws + OFF_X);
    const int wave = threadIdx.x >> 6, lane = threadIdx.x & 63;
    for (int r = blockIdx.x * 8 + wave; r < R; r += gridDim.x * 8) {
        int seq, pos; row_info(r, seq, pos);
        const float* src = nullptr;
        if (pos >= 32) { const long orow = (long)r - 32 * (seq + 1); src = orow < 65536 ? p.in[0] + orow * 1024 : p.in[1] + (orow - 65536) * 1024; }
        else if (pos >= 16) src = p.in[2] + (size_t)(pos - 16) * 1024;
        float sq = 0.f;
#pragma unroll
        for (int j = 0; j < 4; ++j) {
            f32x4 v = {0.f, 0.f, 0.f, 0.f};
            if (src) v = *(const f32x4*)(src + j * 256 + lane * 4);
            sq += (v[0] * v[0] + v[1] * v[1]) + (v[2] * v[2] + v[3] * v[3]);
            u32x2 w; w.x = cvt_pk_bf16(v[0], v[1]); w.y = cvt_pk_bf16(v[2], v[3]);
            *(u32x2*)(hb + (size_t)r * 1024 + j * 256 + lane * 4) = w;
        }
#pragma unroll
        for (int o = 32; o >= 1; o >>= 1) sq += __shfl_xor(sq, o);
        if (lane == 0) { ss[r] = sq; ss[R + r] = 0.f; ss[2 * R + r] = 0.f; ss[3 * R + r] = 0.f; }
    }
}

constexpr int SC_QT = 0, SC_KT = 8704, SC_KTT = 17408, SC_VT = 27648, SC_TOT = 37888, SC_E1 = 39936, SC_E2 = 40448, SC_BUF = 40960;
#ifdef NAIVE_SCAN
__device__ __forceinline__ void scan_job(LAS unsigned char* lds, const Params& p, int job) {
    unsigned char* ws = p.ws;
    const bf16_t* qb = (const bf16_t*)(ws + OFF_Y + Y_Q);
    const bf16_t* vb = (const bf16_t*)(ws + OFF_Y + Y_V);
    unsigned short* lfo = (unsigned short*)(ws + OFF_Y + Y_LFO);
    int seq, head, dir;
    if (job < 64) { seq = 32 + (job >> 3); head = (job >> 1) & 3; dir = job & 1; } else { const int jj = job - 64; seq = jj >> 3; head = (jj >> 1) & 3; dir = jj & 1; }
    const int nch = seq < 32 ? LP / 32 : LS / 32;
    const int rb = seq < 32 ? seq * LP : RP + (seq - 32) * LS;
    const int t = threadIdx.x, dv = t & 127, kq = t >> 7;
    const size_t fcol = (size_t)dir * 512 + head * 128, qcol = (size_t)head * 128;
    LAS float* Fs = (LAS float*)lds; LAS float* Qs = Fs + 4096; LAS float* Vs = Qs + 4096; LAS float* Os = Vs + 4096;
    float S[32];
#pragma unroll
    for (int k = 0; k < 32; ++k) S[k] = 0.f;
    for (int cc = 0; cc < nch; ++cc) {
        const int c = dir ? nch - 1 - cc : cc;
#pragma unroll
        for (int j = 0; j < 8; ++j) { const int idx = j * 512 + t, i = idx >> 7, ch = idx & 127; const size_t r = (size_t)rb + c * 32 + (dir ? 31 - i : i);
            Fs[idx] = h2f(lfo[r * 1024 + fcol + ch]); Qs[idx] = bf2f(qb[r * 512 + qcol + ch]); Vs[idx] = bf2f(vb[r * 512 + qcol + ch]); }
        __syncthreads();
        for (int i = 0; i < 32; ++i) {
            const float v = Vs[i * 128 + dv]; float o = 0.f;
#pragma unroll
            for (int kk = 0; kk < 32; ++kk) { const float f = Fs[i * 128 + kq * 32 + kk]; S[kk] = f * S[kk] + (1.0f - f) * v; o += S[kk] * Qs[i * 128 + kq * 32 + kk]; }
            Os[(kq * 32 + i) * 128 + dv] = o;
        }
        __syncthreads();
#pragma unroll
        for (int j = 0; j < 8; ++j) { const int idx = j * 512 + t, i = idx >> 7, d = idx & 127; const size_t r = (size_t)rb + c * 32 + (dir ? 31 - i : i);
            const float o = (Os[i * 128 + d] + Os[(32 + i) * 128 + d]) + (Os[(64 + i) * 128 + d] + Os[(96 + i) * 128 + d]);
            lfo[r * 1024 + fcol + d] = (unsigned short)(cvt_pk_bf16(o, 0.f) & 0xffff); }
        __syncthreads();
    }
}
#else
__device__ __forceinline__ void scan_job(LAS unsigned char* lds, const Params& p, int job) {
    unsigned char* ws = p.ws;
    const bf16_t* qb = (const bf16_t*)(ws + OFF_Y + Y_Q);
    const bf16_t* vb = (const bf16_t*)(ws + OFF_Y + Y_V);
    unsigned short* lfo = (unsigned short*)(ws + OFF_Y + Y_LFO);
    int seq, head, dir;
    if (job < 64) { seq = 32 + (job >> 3); head = (job >> 1) & 3; dir = job & 1; } else { const int jj = job - 64; seq = jj >> 3; head = (jj >> 1) & 3; dir = jj & 1; }
    const int nch = seq < 32 ? LP / 32 : LS / 32;
    const int rb = seq < 32 ? seq * LP : RP + (seq - 32) * LS;
    const int t = threadIdx.x, lane = t & 63, w = __builtin_amdgcn_readfirstlane(t >> 6), g = lane >> 4, l15 = lane & 15;
    const int ch = t & 127, seg = t >> 7;
    const size_t fcol = (size_t)dir * 512 + head * 128, qcol = (size_t)head * 128;
    f32x4 S[8];
#pragma unroll
    for (int k = 0; k < 8; ++k) S[k] = (f32x4){0.f, 0.f, 0.f, 0.f};
    unsigned short fr_[8], qr_[8], vr_[8];
    { const int c = dir ? nch - 1 : 0;
#pragma unroll
      for (int j = 0; j < 8; ++j) { const int i = seg * 8 + j; const size_t r = (size_t)rb + c * 32 + (dir ? 31 - i : i);
          fr_[j] = lfo[r * 1024 + fcol + ch]; qr_[j] = qb[r * 512 + qcol + ch]; vr_[j] = vb[r * 512 + qcol + ch]; } }
    for (int cc = 0; cc < nch; ++cc) {
        LAS unsigned char* B = lds + (cc & 1) * SC_BUF;
        const int c = dir ? nch - 1 - cc : cc;
        float f[8], P[8];
#pragma unroll
        for (int j = 0; j < 8; ++j) f[j] = h2f(fr_[j]);
        P[0] = f[0];
#pragma unroll
        for (int j = 1; j < 8; ++j) P[j] = P[j - 1] * f[j];
        LAS float* tot = (LAS float*)(B + SC_TOT);
        tot[seg * 128 + ch] = P[7];
        __syncthreads();
        const float t0 = tot[ch], t1 = tot[128 + ch], t2 = tot[256 + ch], t3 = tot[384 + ch];
        const float P15 = t0 * t1, P31 = P15 * t2 * t3;
        const float pre = seg == 0 ? 1.0f : (seg == 1 ? t0 : (seg == 2 ? P15 : P15 * t2));
        const float inv15 = 1.0f / P15;
        const float sc = pre * inv15;
        unsigned short kt8[8];
#pragma unroll
        for (int j = 0; j < 8; ++j) {
            const float E = P[j] * sc, Ri = __builtin_amdgcn_rcpf(E);
            const float qt = bf2f(qr_[j]) * E, kt = (1.0f - f[j]) * Ri;
            const unsigned pk = cvt_pk_bf16(qt, kt);
            const int i = seg * 8 + j;
            *(LAS unsigned short*)(B + SC_QT + i * 272 + ch * 2) = (unsigned short)(pk & 0xffff);
            *(LAS unsigned short*)(B + SC_KT + i * 272 + ch * 2) = (unsigned short)(pk >> 16);
            kt8[j] = (unsigned short)(pk >> 16);
        }
        { u32x4 wk; wk.x = kt8[0] | ((unsigned)kt8[1] << 16); wk.y = kt8[2] | ((unsigned)kt8[3] << 16); wk.z = kt8[4] | ((unsigned)kt8[5] << 16); wk.w = kt8[6] | ((unsigned)kt8[7] << 16);
          *(LAS u32x4*)(B + SC_KTT + ch * 80 + seg * 16) = wk;
          u32x4 wv; wv.x = vr_[0] | ((unsigned)vr_[1] << 16); wv.y = vr_[2] | ((unsigned)vr_[3] << 16); wv.z = vr_[4] | ((unsigned)vr_[5] << 16); wv.w = vr_[6] | ((unsigned)vr_[7] << 16);
          *(LAS u32x4*)(B + SC_VT + ch * 80 + seg * 16) = wv; }
        if (seg == 0) { ((LAS float*)(B + SC_E1))[ch] = P15; ((LAS float*)(B + SC_E2))[ch] = P31 * inv15; }
        if (cc + 1 < nch) { const int c2 = dir ? nch - 2 - cc : cc + 1;
#pragma unroll
            for (int j = 0; j < 8; ++j) { const int i = seg * 8 + j; const size_t r = (size_t)rb + c2 * 32 + (dir ? 31 - i : i);
                fr_[j] = lfo[r * 1024 + fcol + ch]; qr_[j] = qb[r * 512 + qcol + ch]; vr_[j] = vb[r * 512 + qcol + ch]; } }
        __syncthreads();
        bf16x8 Aq[2][4], Ak[2][4];
#pragma unroll
        for (int it = 0; it < 2; ++it)
#pragma unroll
            for (int ks = 0; ks < 4; ++ks) {
                const LAS unsigned char* qa = B + SC_QT + (it * 16 + l15) * 272 + (ks * 32 + g * 4) * 2;
                const LAS unsigned char* ka = B + SC_KT + (it * 16 + l15) * 272 + (ks * 32 + g * 4) * 2;
                const u32x2 q0 = *(const LAS u32x2*)qa, q1 = *(const LAS u32x2*)(qa + 32), k0 = *(const LAS u32x2*)ka, k1 = *(const LAS u32x2*)(ka + 32);
                u32x4 qq = {q0.x, q0.y, q1.x, q1.y}, kk = {k0.x, k0.y, k1.x, k1.y};
                Aq[it][ks] = __builtin_bit_cast(bf16x8, qq); Ak[it][ks] = __builtin_bit_cast(bf16x8, kk);
            }
#pragma unroll
        for (int kt = 0; kt < 8; ++kt) S[kt] *= *(const LAS f32x4*)(B + SC_E1 + (kt * 16 + g * 4) * 4);
        f32x4 o0 = {0.f, 0.f, 0.f, 0.f}, o1 = o0, c00 = o0, c01 = o0, c11 = o0;
#pragma unroll
        for (int ks = 0; ks < 4; ++ks) {
            u32x4 sw; sw.x = cvt_pk_bf16(S[2 * ks][0], S[2 * ks][1]); sw.y = cvt_pk_bf16(S[2 * ks][2], S[2 * ks][3]); sw.z = cvt_pk_bf16(S[2 * ks + 1][0], S[2 * ks + 1][1]); sw.w = cvt_pk_bf16(S[2 * ks + 1][2], S[2 * ks + 1][3]);
            const bf16x8 Sf = __builtin_bit_cast(bf16x8, sw);
            o0 = __builtin_amdgcn_mfma_f32_16x16x32_bf16(Aq[0][ks], Sf, o0, 0, 0, 0);
            o1 = __builtin_amdgcn_mfma_f32_16x16x32_bf16(Aq[1][ks], Sf, o1, 0, 0, 0);
            c00 = __builtin_amdgcn_mfma_f32_16x16x32_bf16(Ak[0][ks], Aq[0][ks], c00, 0, 0, 0);
            c01 = __builtin_amdgcn_mfma_f32_16x16x32_bf16(Ak[0][ks], Aq[1][ks], c01, 0, 0, 0);
            c11 = __builtin_amdgcn_mfma_f32_16x16x32_bf16(Ak[1][ks], Aq[1][ks], c11, 0, 0, 0);
        }
#pragma unroll
        for (int e = 0; e < 4; ++e) { const bool keep = (g * 4 + e) <= l15; c00[e] = keep ? c00[e] : 0.f; c11[e] = keep ? c11[e] : 0.f; }
        { u32x4 pw; pw.x = cvt_pk_bf16(c00[0], c00[1]); pw.y = cvt_pk_bf16(c00[2], c00[3]); pw.z = 0u; pw.w = 0u;
          u32x4 pw1; pw1.x = cvt_pk_bf16(c01[0], c01[1]); pw1.y = cvt_pk_bf16(c01[2], c01[3]); pw1.z = cvt_pk_bf16(c11[0], c11[1]); pw1.w = cvt_pk_bf16(c11[2], c11[3]);
          const LAS unsigned char* va = B + SC_VT + (w * 16 + l15) * 80;
          const u32x2 v0 = *(const LAS u32x2*)(va + g * 8), v1 = *(const LAS u32x2*)(va + 32 + g * 8);
          u32x4 vp = {v0.x, v0.y, v1.x, v1.y};
          const bf16x8 Vp = __builtin_bit_cast(bf16x8, vp);
          o0 = __builtin_amdgcn_mfma_f32_16x16x32_bf16(__builtin_bit_cast(bf16x8, pw), Vp, o0, 0, 0, 0);
          o1 = __builtin_amdgcn_mfma_f32_16x16x32_bf16(__builtin_bit_cast(bf16x8, pw1), Vp, o1, 0, 0, 0);
          const bf16x8 Vn = *(const LAS bf16x8*)(va + g * 16);
#pragma unroll
          for (int kt = 0; kt < 8; ++kt) {
              const bf16x8 Ka = *(const LAS bf16x8*)(B + SC_KTT + (kt * 16 + l15) * 80 + g * 16);
              S[kt] = __builtin_amdgcn_mfma_f32_16x16x32_bf16(Ka, Vn, S[kt], 0, 0, 0);
          }
        }
#pragma unroll
        for (int kt = 0; kt < 8; ++kt) S[kt] *= *(const LAS f32x4*)(B + SC_E2 + (kt * 16 + g * 4) * 4);
#pragma unroll
        for (int e = 0; e < 4; ++e) {
            const int i0 = g * 4 + e, i1 = 16 + g * 4 + e;
            const size_t r0 = (size_t)rb + c * 32 + (dir ? 31 - i0 : i0), r1 = (size_t)rb + c * 32 + (dir ? 31 - i1 : i1);
            lfo[r0 * 1024 + fcol + w * 16 + l15] = (unsigned short)(cvt_pk_bf16(o0[e], 0.f) & 0xffff);
            lfo[r1 * 1024 + fcol + w * 16 + l15] = (unsigned short)(cvt_pk_bf16(o1[e], 0.f) & 0xffff);
        }
    }
    __syncthreads();
}
#endif
__device__ __forceinline__ void phase_scan(LAS unsigned char* lds, const Params& p) {
    const int b = blockIdx.x;
    const bool stdg = gridDim.x == 256;
    for (int it = 0;; ++it) {
        int job;
        if (stdg) { if (it == 0) job = b; else if (it == 1 && b >= 64 && b < 128) job = b + 192; else break; }
        else { job = b + it * (int)gridDim.x; if (job >= 320) break; }
        scan_job(lds, p, job);
    }
}

__device__ __forceinline__ void phase_mix(LAS unsigned char* lds, const Params& p) {
    unsigned char* ws = p.ws;
    const bf16_t* gate = (const bf16_t*)(ws + OFF_Y + Y_Q);
    const bf16_t* glu = (const bf16_t*)(ws + OFF_Y + Y_V);
    bf16_t* mix = (bf16_t*)(ws + OFF_Y + Y_LFO);
    const int t = threadIdx.x, lane = t & 63, w = t >> 6;
    float cw[31];
#pragma unroll
    for (int j = 0; j < 31; ++j) cw[j] = p.in[11][j * 512 + t];
    const float cb = p.in[12][t];
    LAS float* tile = (LAS float*)lds;
    float lg[8], lb_[8], hn[8];
#pragma unroll
    for (int e = 0; e < 8; ++e) { lg[e] = p.in[13][lane * 8 + e]; lb_[e] = p.in[14][lane * 8 + e]; hn[e] = p.in[10][lane * 8 + e]; }
    for (int tix = blockIdx.x; tix < R / 32; tix += gridDim.x) {
        const int r0 = tix * 32;
        float x[62];
#pragma unroll
        for (int i = 0; i < 62; ++i) { const int r = r0 - 15 + i; x[i] = (r >= 0 && r < R) ? bf2f(glu[(size_t)r * 512 + t]) : 0.f; }
#pragma unroll
        for (int i = 0; i < 32; ++i) { float a = cb;
#pragma unroll
            for (int j = 0; j < 31; ++j) a += cw[j] * x[i + j];
            tile[i * 512 + t] = a; }
        __syncthreads();
#pragma unroll
        for (int rr = 0; rr < 4; ++rr) {
            const int i = w * 4 + rr; const size_t r = (size_t)r0 + i;
            { const u32x4 a = *(const u32x4*)(mix + r * 1024 + lane * 8), b = *(const u32x4*)(mix + r * 1024 + 512 + lane * 8), gt = *(const u32x4*)(gate + r * 512 + lane * 8);
              float o[8] = {bflo(a.x) + bflo(b.x), bfhi(a.x) + bfhi(b.x), bflo(a.y) + bflo(b.y), bfhi(a.y) + bfhi(b.y), bflo(a.z) + bflo(b.z), bfhi(a.z) + bfhi(b.z), bflo(a.w) + bflo(b.w), bfhi(a.w) + bfhi(b.w)};
              const float gg[8] = {bflo(gt.x), bfhi(gt.x), bflo(gt.y), bfhi(gt.y), bflo(gt.z), bfhi(gt.z), bflo(gt.w), bfhi(gt.w)};
              float sq = 0.f;
#pragma unroll
              for (int e = 0; e < 8; ++e) sq += o[e] * o[e];
              sq += __shfl_xor(sq, 1); sq += __shfl_xor(sq, 2); sq += __shfl_xor(sq, 4); sq += __shfl_xor(sq, 8);
              const float rs = __builtin_amdgcn_rsqf(sq * (1.0f / 128.0f) + RMS_EPS);
#pragma unroll
              for (int e = 0; e < 8; ++e) o[e] = o[e] * rs * hn[e] * gg[e];
              u32x4 wv; wv.x = cvt_pk_bf16(o[0], o[1]); wv.y = cvt_pk_bf16(o[2], o[3]); wv.z = cvt_pk_bf16(o[4], o[5]); wv.w = cvt_pk_bf16(o[6], o[7]);
              *(u32x4*)(mix + r * 1024 + lane * 8) = wv; }
            { const f32x4 y0 = *(const LAS f32x4*)(tile + i * 512 + lane * 8), y1 = *(const LAS f32x4*)(tile + i * 512 + lane * 8 + 4);
              float y[8] = {y0[0], y0[1], y0[2], y0[3], y1[0], y1[1], y1[2], y1[3]};
              float s = 0.f;
#pragma unroll
              for (int e = 0; e < 8; ++e) s += y[e];
#pragma unroll
              for (int o = 32; o >= 1; o >>= 1) s += __shfl_xor(s, o);
              const float mu = s * (1.0f / 512.0f); float q = 0.f;
#pragma unroll
              for (int e = 0; e < 8; ++e) { y[e] -= mu; q += y[e] * y[e]; }
#pragma unroll
              for (int o = 32; o >= 1; o >>= 1) q += __shfl_xor(q, o);
              const float rs = __builtin_amdgcn_rsqf(q * (1.0f / 512.0f) + LN_EPS);
#pragma unroll
              for (int e = 0; e < 8; ++e) y[e] = siluf_(y[e] * rs * lg[e] + lb_[e]);
              u32x4 wv; wv.x = cvt_pk_bf16(y[0], y[1]); wv.y = cvt_pk_bf16(y[2], y[3]); wv.z = cvt_pk_bf16(y[4], y[5]); wv.w = cvt_pk_bf16(y[6], y[7]);
              *(u32x4*)(mix + r * 1024 + 512 + lane * 8) = wv; }
        }
        __syncthreads();
    }
}

__device__ __forceinline__ void phase_final(const Params& p) {
    const float* ss3 = (const float*)(p.ws + OFF_SS) + 3 * (size_t)R;
    const int wave = threadIdx.x >> 6, lane = threadIdx.x & 63;
    f32x4 g[4];
#pragma unroll
    for (int j = 0; j < 4; ++j) g[j] = *(const f32x4*)(p.in[20] + j * 256 + lane * 4);
    for (int r = blockIdx.x * 8 + wave; r < R; r += gridDim.x * 8) {
        int seq, pos; row_info(r, seq, pos);
        if (pos < 32) continue;
        float* op = p.out + ((long)r - 32 * (seq + 1)) * 1024;
        const float s = __builtin_amdgcn_rsqf(ss3[r] * (1.0f / 1024.0f) + RMS_EPS);
#pragma unroll
        for (int j = 0; j < 4; ++j) { f32x4 v = *(const f32x4*)(op + j * 256 + lane * 4); v = v * s * g[j]; *(f32x4*)(op + j * 256 + lane * 4) = v; }
    }
}

__global__ void __launch_bounds__(NTHREADS, 2) hymba_fwd(Params p) {
    extern __shared__ __attribute__((aligned(16))) unsigned char lds_raw[];
    LAS unsigned char* lds = (LAS unsigned char*)lds_raw;
    unsigned char* ws = p.ws;
    float* ss = (float*)(ws + OFF_SS);
    bf16_t* hb = (bf16_t*)(ws + OFF_X);
    bf16_t* Y = (bf16_t*)(ws + OFF_Y);
    const int lo = p.ph_lo, hi = p.ph_hi;
#define IN(k) (lo <= (k) && (k) < hi)
#if COOP
#define SEAM(k) do { if (IN(k) && IN((k) + 1)) { asm volatile("s_waitcnt vmcnt(0) lgkmcnt(0)" ::: "memory"); __syncthreads(); cg::this_grid().sync(); } } while (0)
#else
#define SEAM(k) do { } while (0)
#endif
    #ifndef SKIP_PREP
    if (IN(0)) phase_prep(lds, p);
#endif
    SEAM(0);
    if (IN(1)) { EpiPair<0> E{Y, FF, 0, ss}; pg8::gemm_phase(lds, hb, (const bf16_t*)(ws + OFF_W1), R, 5632, 1024, E); }
    SEAM(1);
    if (IN(2)) { EpiRes<0> E{p.in[0], p.in[1], p.in[2], p.out, hb, ss + R}; pg8::gemm_phase(lds, Y, (const bf16_t*)(ws + OFF_W2), R, 1024, FF, E); }
    SEAM(2);
    if (IN(3)) { EpiZa E{(bf16_t*)(ws + OFF_Y + Y_Q), (bf16_t*)(ws + OFF_Y + Y_V), (unsigned short*)(ws + OFF_Y + Y_LFO), ss + R, (const float*)(ws + OFF_LB)};
        pg8::gemm_phase(lds, hb, (const bf16_t*)(ws + OFF_W3A), R, 2048, 1024, E); }
    SEAM(3);
    #ifndef SKIP_SCAN
    if (IN(4)) phase_scan(lds, p);
#endif
    SEAM(4);
    if (IN(5)) { EpiZb E{(bf16_t*)(ws + OFF_Y + Y_Q), (bf16_t*)(ws + OFF_Y + Y_V), ss + R}; pg8::gemm_phase(lds, hb, (const bf16_t*)(ws + OFF_W3B), R, 1536, 1024, E); }
    SEAM(5);
    #ifndef SKIP_MIX
    if (IN(6)) phase_mix(lds, p);
#endif
    SEAM(6);
    if (IN(7)) { EpiRes<1> E{p.in[0], p.in[1], p.in[2], p.out, hb, ss + 2 * R}; pg8::gemm_phase(lds, (const bf16_t*)(ws + OFF_Y + Y_LFO), (const bf16_t*)(ws + OFF_W4), R, 1024, 1024, E); }
    SEAM(7);
    if (IN(8)) { EpiPair<0> E{Y, FF, 0, ss + 2 * R}; pg8::gemm_phase(lds, hb, (const bf16_t*)(ws + OFF_W5), R, 5632, 1024, E); }
    SEAM(8);
    if (IN(9)) { EpiRes<2> E{p.in[0], p.in[1], p.in[2], p.out, hb, ss + 3 * R}; pg8::gemm_phase(lds, Y, (const bf16_t*)(ws + OFF_W6), R, 1024, FF, E); }
    SEAM(9);
    if (IN(10)) phase_final(p);
#undef IN
#undef SEAM
}

extern "C" void kernel_launch(void* const* d_in, const int* in_sizes, int n_in, void* d_out, int out_size, void* d_ws, size_t ws_size, hipStream_t stream) {
    constexpr int LDS_BYTES = 131072;
    static int grid = 0;
    if (grid == 0) {
        if (n_in != 21 || ws_size < WS_END) { fprintf(stderr, "kernel_launch: need 21 inputs and %zu bytes of workspace; got %d, %zu\n", (size_t)WS_END, n_in, ws_size); grid = -1; return; }
        int dev = 0, cus = 0, per_cu = 0;
        (void)hipGetDevice(&dev); (void)hipDeviceGetAttribute(&cus, hipDeviceAttributeMultiprocessorCount, dev);
        if (hipFuncSetAttribute((const void*)hymba_fwd, hipFuncAttributeMaxDynamicSharedMemorySize, LDS_BYTES) != hipSuccess) { fprintf(stderr, "kernel_launch: hipFuncSetAttribute failed\n"); grid = -1; return; }
        if (hipOccupancyMaxActiveBlocksPerMultiprocessor(&per_cu, (const void*)hymba_fwd, NTHREADS, LDS_BYTES) != hipSuccess || per_cu < 1) per_cu = 1;
        (void)hipGetLastError();
        grid = cus * 1;
        if (grid <= 0) grid = 256;
    }
    if (grid < 0) return;
    Params p{};
    for (int i = 0; i < 21; ++i) p.in[i] = (const float*)d_in[i];
    p.out = (float*)d_out; p.ws = (unsigned char*)d_ws;
#if COOP
    p.ph_lo = 0; p.ph_hi = 11;
    void* args[] = {&p};
    hipError_t e = hipLaunchCooperativeKernel((const void*)hymba_fwd, dim3(grid), dim3(NTHREADS), args, LDS_BYTES, stream);
    if (e != hipSuccess) fprintf(stderr, "cooperative launch failed: %s (grid %d)\n", hipGetErrorString(e), grid);
#else
    for (int ph = 0; ph < 11; ++ph) { p.ph_lo = ph; p.ph_hi = ph + 1; hipLaunchKernelGGL(hymba_fwd, dim3(grid), dim3(NTHREADS), LDS_BYTES, stream, p); }
#endif
}
```

```cpp
#include <hip/hip_runtime.h>
#include <hip/hip_cooperative_groups.h>
#include <cstdio>
namespace cg = cooperative_groups;

#define LAS __attribute__((address_space(3)))
typedef unsigned short bf16_t;
typedef short bf16x8 __attribute__((ext_vector_type(8)));
typedef float f32x4 __attribute__((ext_vector_type(4)));
typedef unsigned u32x4 __attribute__((ext_vector_type(4)));
typedef unsigned u32x2 __attribute__((ext_vector_type(2)));

#ifndef COOP
#define COOP 1
#endif
#ifndef STAG
#define STAG 0
#endif

constexpr int D = 1024, FF = 2816;
constexpr int LP = 2080, LS = 8224;
constexpr int RP = 32 * LP;
constexpr int R = RP + 8 * LS;
constexpr int NRC = 131072;
constexpr int NTHREADS = 512;
constexpr float RMS_EPS = 1e-6f, LN_EPS = 1e-5f;

constexpr size_t SZ_W1 = (size_t)5632 * 1024 * 2, SZ_W2 = (size_t)1024 * 2816 * 2, SZ_W3A = (size_t)2048 * 1024 * 2, SZ_W3B = (size_t)1536 * 1024 * 2, SZ_W4 = (size_t)1024 * 1024 * 2;
constexpr size_t OFF_W1 = 0, OFF_W2 = OFF_W1 + SZ_W1, OFF_W3A = OFF_W2 + SZ_W2, OFF_W3B = OFF_W3A + SZ_W3A, OFF_W4 = OFF_W3B + SZ_W3B, OFF_W5 = OFF_W4 + SZ_W4, OFF_W6 = OFF_W5 + SZ_W1;
constexpr size_t OFF_SS = OFF_W6 + SZ_W2;
constexpr size_t OFF_LB = OFF_SS + (size_t)4 * R * 4;
constexpr size_t OFF_BAR = OFF_LB + 4096;
constexpr size_t OFF_META = OFF_BAR + 16384;
constexpr size_t OFF_X = OFF_META + 262144;
constexpr size_t OFF_Y = OFF_X + (size_t)R * 1024 * 2;
constexpr size_t WS_END = OFF_Y + (size_t)R * 2816 * 2;
constexpr size_t Y_Q = 0, Y_V = (size_t)R * 1024, Y_LFO = (size_t)2 * R * 1024, Y_GLU = (size_t)4 * R * 1024;

struct Params { const float* in[21]; float* out; unsigned char* ws; int ph_lo, ph_hi; };

typedef __bf16 bf16v2_t __attribute__((ext_vector_type(2)));
typedef float f32x2_t __attribute__((ext_vector_type(2)));
__device__ __forceinline__ unsigned cvt_pk_bf16(float lo, float hi) { const f32x2_t v = {lo, hi}; const bf16v2_t b = __builtin_convertvector(v, bf16v2_t); return __builtin_bit_cast(unsigned, b); }
__device__ __forceinline__ float bf2f(unsigned short b) { return __uint_as_float(((unsigned)b) << 16); }
__device__ __forceinline__ float bflo(unsigned w) { return __uint_as_float(w << 16); }
__device__ __forceinline__ float bfhi(unsigned w) { return __uint_as_float(w & 0xffff0000u); }
__device__ __forceinline__ unsigned short f2h(float f) { return __builtin_bit_cast(unsigned short, (_Float16)f); }
__device__ __forceinline__ float h2f(unsigned short h) { return (float)__builtin_bit_cast(_Float16, h); }
__device__ __forceinline__ float sigmoidf_(float x) { return __builtin_amdgcn_rcpf(1.0f + __expf(-x)); }
__device__ __forceinline__ float siluf_(float x) { return x * sigmoidf_(x); }
__device__ __forceinline__ void row_info(int r, int& seq, int& pos) {
    if (r < RP) { seq = r / LP; pos = r - seq * LP; } else { const int q = (r - RP) / LS; seq = 32 + q; pos = (r - RP) - q * LS; }
}

__device__ __forceinline__ int pad_row(int o) { return o + 32 * ((o < 65536 ? (o >> 11) : 32 + ((o - 65536) >> 13)) + 1); }

namespace pg8 {
constexpr int BM = 256, BK = 64, HALF = 128, HTB = HALF * BK * 2, STAGE_BYTES = 8 * HTB, NXCD = 8, WGM = 8;
__host__ __device__ __forceinline__ int lds_byte(int r, int c) { const int st = (r >> 4) * 2 + (c >> 5), rr = r & 15, cc = c & 31, ob = rr * 64 + cc * 2; return st * 1024 + (ob ^ (((ob >> 9) & 1) << 5)); }
__host__ __device__ __forceinline__ void stage_rc(int b, int& Rr, int& C) { const int st = b / 1024, sb = b % 1024, swz = sb ^ (((sb >> 9) & 1) << 5); Rr = (st >> 1) * 16 + swz / 64; C = (st & 1) * 32 + (swz % 64) / 2; }
__host__ __device__ __forceinline__ int perm32(int rho) { const int n = rho >> 4, i = rho & 15; return 8 * (i >> 2) + 4 * n + (i & 3); }
struct Unit { int pm, pn; };
struct StaticOrder {
    int nM, nN, nwg, G, c;
    __device__ void init(int M, int N, int G_, int c_) { nM = M / BM; nN = N / BM; nwg = nM * nN; G = G_; c = c_; }
    __device__ bool next(int i, Unit& u) const {
        const long L = (long)i * G + c; if (L >= nwg) return false;
        int wgid = (int)L; { const int q = nwg / NXCD, r = nwg % NXCD, xcd = wgid % NXCD, off = wgid / NXCD; wgid = (xcd < r ? xcd * (q + 1) : r * (q + 1) + (xcd - r) * q) + off; }
        const int nig = WGM * nN, gid = wgid / nig, fm = gid * WGM, gsz = (nM - fm) < WGM ? (nM - fm) : WGM;
        u.pm = fm + ((wgid % nig) % gsz); u.pn = (wgid % nig) / gsz; return true;
    }
};
template <class Epi>
__device__ __forceinline__ void gemm_phase(LAS unsigned char* lds, const bf16_t* A, const bf16_t* Bt, int M, int N, int K, const Epi& E, int stag_ticks = 0) {
    const int tid = threadIdx.x, wid = __builtin_amdgcn_readfirstlane(tid >> 6), lane = tid & 63, wr = wid >> 2, wc = wid & 3, fr = lane & 15, fq = lane >> 4;
    const int nt = K / BK;
    StaticOrder S; S.init(M, N, (int)gridDim.x, (int)blockIdx.x);
    unsigned voffA[2], voffB[2];
#pragma unroll
    for (int i = 0; i < 2; ++i) { int Rr, C; stage_rc(tid * 16 + i * 8192, Rr, C); const int Rb = (Rr & ~31) + perm32(Rr & 31);
        voffA[i] = (unsigned)(Rr * K + C) * 2u; voffB[i] = (unsigned)(Rb * K + C) * 2u; }
    const size_t kstep = (size_t)(BK * 2);
    const size_t hstep = (size_t)HALF * K * 2;
    const size_t tstep = 2 * hstep;
    const unsigned ldsw = (unsigned)wid * 1024u;
    const int aoff = lds_byte(wr * 64 + fr, fq * 8), boff = lds_byte(wc * 32 + fr, fq * 8);
#define PG8_SA(b, h) (((b) * 2 + (h)) * HTB)
#define PG8_SB(b, h) ((4 + (b) * 2 + (h)) * HTB)
#define PG8_STAGE(bufoff, gbase, voff) do { _Pragma("unroll") for (int _i = 0; _i < 2; ++_i) \
        __builtin_amdgcn_global_load_lds((const unsigned*)((const char*)(gbase) + (voff)[_i]), (LAS unsigned*)(lds + (bufoff) + ldsw + _i * 8192), 16, 0, 0); } while (0)
#define PG8_LDA(dst, b, h) do { _Pragma("unroll") for (int m = 0; m < 4; ++m) _Pragma("unroll") for (int k = 0; k < 2; ++k) dst[m][k] = *(const LAS bf16x8*)(lds + PG8_SA(b, h) + aoff + m * 2048 + k * 1024); } while (0)
#define PG8_LDB(dst, b, h) do { _Pragma("unroll") for (int n = 0; n < 2; ++n) _Pragma("unroll") for (int k = 0; k < 2; ++k) dst[n][k] = *(const LAS bf16x8*)(lds + PG8_SB(b, h) + boff + n * 2048 + k * 1024); } while (0)
#define PG8_MMA(ai, bj, At, Bt_) do { __builtin_amdgcn_s_setprio(1); _Pragma("unroll") for (int m = 0; m < 4; ++m) _Pragma("unroll") for (int n = 0; n < 2; ++n) _Pragma("unroll") for (int k = 0; k < 2; ++k) \
        acc[ai][bj][m][n] = __builtin_amdgcn_mfma_f32_16x16x32_bf16(Bt_[n][k], At[m][k], acc[ai][bj][m][n], 0, 0, 0); __builtin_amdgcn_s_setprio(0); } while (0)
#define PG8_WAIT_V(n) asm volatile("s_waitcnt vmcnt(" #n ")" ::: "memory")
#define PG8_WAIT_L(n) asm volatile("s_waitcnt lgkmcnt(" #n ")" ::: "memory")
#define PG8_BAR __builtin_amdgcn_s_barrier()
#define PG8_SCHED __builtin_amdgcn_sched_barrier(0)
    Unit cur, nxt; int ui = 0;
    if (!S.next(0, cur)) return;
    if (stag_ticks) { const unsigned long long t0 = __builtin_amdgcn_s_memrealtime(), tgt = (unsigned long long)(((blockIdx.x >> 3) & 3) * stag_ticks);
        while (__builtin_amdgcn_s_memrealtime() - t0 < tgt) __builtin_amdgcn_s_sleep(4); }
    f32x4 acc[2][2][4][2];
#pragma unroll
    for (int a = 0; a < 2; ++a)
#pragma unroll
        for (int b = 0; b < 2; ++b)
#pragma unroll
            for (int m = 0; m < 4; ++m)
#pragma unroll
                for (int n = 0; n < 2; ++n) acc[a][b][m][n] = (f32x4){0.f, 0.f, 0.f, 0.f};
    bf16x8 At[4][2], B0[2][2], B1[2][2];
    const char* cA = (const char*)A + (size_t)cur.pm * tstep; const char* cB = (const char*)Bt + (size_t)cur.pn * tstep;
    PG8_STAGE(PG8_SB(0, 0), cB, voffB); PG8_STAGE(PG8_SA(0, 0), cA, voffA); PG8_STAGE(PG8_SB(0, 1), cB + hstep, voffB); PG8_STAGE(PG8_SA(0, 1), cA + hstep, voffA);
    if (wr == 1) PG8_BAR;
    PG8_WAIT_V(4); PG8_BAR;
    PG8_STAGE(PG8_SB(1, 0), cB + kstep, voffB); PG8_STAGE(PG8_SA(1, 0), cA + kstep, voffA); PG8_STAGE(PG8_SB(1, 1), cB + hstep + kstep, voffB);
    PG8_WAIT_V(6); PG8_BAR;
    for (;;) {
        const bool has_next = S.next(ui + 1, nxt);
        const char* nA = has_next ? (const char*)A + (size_t)nxt.pm * tstep : cA; const char* nB = has_next ? (const char*)Bt + (size_t)nxt.pn * tstep : cB;
        for (int t = 0; t < nt; t += 2) {
            const bool last = (t == nt - 2);
            const char* a1 = cA + (size_t)(t + 1) * kstep;
            const char* a2 = last ? nA : cA + (size_t)(t + 2) * kstep; const char* b2 = last ? nB : cB + (size_t)(t + 2) * kstep;
            const char* a3 = a2 + kstep; const char* b3 = b2 + kstep;
            PG8_LDB(B0, 0, 0); PG8_SCHED; PG8_LDA(At, 0, 0); PG8_STAGE(PG8_SA(1, 1), a1 + hstep, voffA);
            PG8_WAIT_L(8); PG8_BAR; PG8_WAIT_L(0); PG8_MMA(0, 0, At, B0); PG8_BAR; PG8_SCHED;
            PG8_LDB(B1, 0, 1); PG8_STAGE(PG8_SB(0, 0), b2, voffB);
            PG8_BAR; PG8_WAIT_L(0); PG8_MMA(0, 1, At, B1); PG8_BAR;
            PG8_LDA(At, 0, 1); PG8_STAGE(PG8_SA(0, 0), a2, voffA);
            PG8_BAR; PG8_WAIT_L(0); PG8_MMA(1, 0, At, B0); PG8_BAR; PG8_SCHED;
            PG8_STAGE(PG8_SB(0, 1), b2 + hstep, voffB);
            PG8_WAIT_V(6); PG8_BAR; PG8_MMA(1, 1, At, B1); PG8_BAR;
            PG8_LDB(B0, 1, 0); PG8_SCHED; PG8_LDA(At, 1, 0); PG8_STAGE(PG8_SA(0, 1), a2 + hstep, voffA);
            PG8_WAIT_L(8); PG8_BAR; PG8_WAIT_L(0); PG8_MMA(0, 0, At, B0); PG8_BAR; PG8_SCHED;
            PG8_LDB(B1, 1, 1); PG8_STAGE(PG8_SB(1, 0), b3, voffB);
            PG8_BAR; PG8_WAIT_L(0); PG8_MMA(0, 1, At, B1); PG8_BAR;
            PG8_LDA(At, 1, 1); PG8_STAGE(PG8_SA(1, 0), a3, voffA);
            PG8_BAR; PG8_WAIT_L(0); PG8_MMA(1, 0, At, B0); PG8_BAR; PG8_SCHED;
            PG8_STAGE(PG8_SB(1, 1), b3 + hstep, voffB);
            PG8_WAIT_V(6); PG8_BAR; PG8_MMA(1, 1, At, B1); PG8_BAR;
        }
        E(acc, cur, wr, wc, fr, fq);
        if (!has_next) break;
#pragma unroll
        for (int a = 0; a < 2; ++a)
#pragma unroll
            for (int b = 0; b < 2; ++b)
#pragma unroll
                for (int m = 0; m < 4; ++m)
#pragma unroll
                    for (int n = 0; n < 2; ++n) acc[a][b][m][n] = (f32x4){0.f, 0.f, 0.f, 0.f};
        cur = nxt; cA = nA; cB = nB; ++ui;
    }
    PG8_WAIT_V(0);
    if (wr == 0) PG8_BAR;
    PG8_BAR;
#undef PG8_SA
#undef PG8_SB
#undef PG8_STAGE
#undef PG8_LDA
#undef PG8_LDB
#undef PG8_MMA
#undef PG8_WAIT_V
#undef PG8_WAIT_L
#undef PG8_BAR
#undef PG8_SCHED
}
}
using pg8::Unit;
typedef f32x4 Acc[2][2][4][2];

template <int MODE> struct EpiPair {
    bf16_t* O; int ldo; int pn0; const float* ss; int padmap;
    __device__ __forceinline__ void operator()(const Acc& acc, const Unit& u, int wr, int wc, int fr, int fq) const {
        const int col = (u.pn - pn0) * 128 + wc * 32 + fq * 8;
        const int rbase = u.pm * 256 + wr * 64 + fr;
        float sv[8];
#pragma unroll
        for (int q = 0; q < 8; ++q) sv[q] = ss[rbase + (q >> 2) * 128 + (q & 3) * 16];
#pragma unroll
        for (int ai = 0; ai < 2; ++ai)
#pragma unroll
            for (int m = 0; m < 4; ++m) {
                const int r = rbase + ai * 128 + m * 16;
                const float s = __builtin_amdgcn_rsqf(sv[ai * 4 + m] * (1.0f / 1024.0f) + RMS_EPS);
                float o[8];
#pragma unroll
                for (int n = 0; n < 2; ++n)
#pragma unroll
                    for (int j = 0; j < 4; ++j) { const float a = acc[ai][0][m][n][j] * s, b = acc[ai][1][m][n][j] * s; o[n * 4 + j] = MODE == 0 ? siluf_(a) * b : a * sigmoidf_(b); }
                u32x4 w; w.x = cvt_pk_bf16(o[0], o[1]); w.y = cvt_pk_bf16(o[2], o[3]); w.z = cvt_pk_bf16(o[4], o[5]); w.w = cvt_pk_bf16(o[6], o[7]);
                *(u32x4*)(O + (size_t)(padmap ? pad_row(r) : r) * ldo + col) = w;
            }
    }
};
template <int MODE> struct EpiRes {
    const bf16_t* src; bf16_t* dst; float* ss;
    __device__ __forceinline__ void operator()(const Acc& acc, const Unit& u, int wr, int wc, int fr, int fq) const {
        const int col0 = u.pn * 256 + wc * 32 + fq * 8;
        const float sc = (MODE == 1) ? 1.0f : 0.5f;
        u32x4 hwa[2][4][2];
#pragma unroll
        for (int ai = 0; ai < 2; ++ai)
#pragma unroll
            for (int m = 0; m < 4; ++m) { int r = u.pm * 256 + ai * 128 + wr * 64 + m * 16 + fr;
                const bf16_t* hp = src + (size_t)r * 1024 + col0; hwa[ai][m][0] = *(const u32x4*)hp; hwa[ai][m][1] = *(const u32x4*)(hp + 128); }
#pragma unroll
        for (int ai = 0; ai < 2; ++ai) {
#pragma unroll
            for (int m = 0; m < 4; ++m) {
                const int r = u.pm * 256 + ai * 128 + wr * 64 + m * 16 + fr;
                bf16_t* hp = dst + (size_t)r * 1024 + col0;
                float sq = 0.f;
#pragma unroll
                for (int bj = 0; bj < 2; ++bj) {
                    const u32x4 h = hwa[ai][m][bj];
                    const f32x4 a0 = acc[ai][bj][m][0] * sc, a1 = acc[ai][bj][m][1] * sc;
                    const float v[8] = {bflo(h.x) + a0[0], bfhi(h.x) + a0[1], bflo(h.y) + a0[2], bfhi(h.y) + a0[3], bflo(h.z) + a1[0], bfhi(h.z) + a1[1], bflo(h.w) + a1[2], bfhi(h.w) + a1[3]};
                    u32x4 w; w.x = cvt_pk_bf16(v[0], v[1]); w.y = cvt_pk_bf16(v[2], v[3]); w.z = cvt_pk_bf16(v[4], v[5]); w.w = cvt_pk_bf16(v[6], v[7]);
                    *(u32x4*)(hp + bj * 128) = w;
                    sq += (v[0] * v[0] + v[1] * v[1]) + (v[2] * v[2] + v[3] * v[3]) + (v[4] * v[4] + v[5] * v[5]) + (v[6] * v[6] + v[7] * v[7]);
                }
                sq += __shfl_xor(sq, 16); sq += __shfl_xor(sq, 32);
                if (fq == 0) atomicAdd(ss + r, sq);
            }
        }
    }
};
struct EpiZa {
    bf16_t* q; bf16_t* v; unsigned short* lfo; const float* ss; const float* lbv;
    template <int KIND> __device__ __forceinline__ void run(const Acc& acc, const Unit& u, int wr, int wc, int fr, int fq) const {
        const int cw = wc * 32 + fq * 8;
        const int rbase = u.pm * 256 + wr * 64 + fr;
        float sv[8];
#pragma unroll
        for (int qq = 0; qq < 8; ++qq) sv[qq] = ss[rbase + (qq >> 2) * 128 + (qq & 3) * 16];
        f32x4 lbr[2][2];
        if (KIND == 1) {
            const int c = (u.pn - 2) * 256 + cw;
#pragma unroll
            for (int bj = 0; bj < 2; ++bj) { lbr[bj][0] = *(const f32x4*)(lbv + c + bj * 128); lbr[bj][1] = *(const f32x4*)(lbv + c + bj * 128 + 4); }
        }
#pragma unroll
        for (int ai = 0; ai < 2; ++ai)
#pragma unroll
            for (int m = 0; m < 4; ++m) {
                const int r = rbase + ai * 128 + m * 16;
                const float s = __builtin_amdgcn_rsqf(sv[ai * 4 + m] * (1.0f / 1024.0f) + RMS_EPS);
                const size_t rp = (size_t)pad_row(r);
#pragma unroll
                for (int bj = 0; bj < 2; ++bj) {
                    float z[8];
#pragma unroll
                    for (int n = 0; n < 2; ++n)
#pragma unroll
                        for (int j = 0; j < 4; ++j) z[n * 4 + j] = acc[ai][bj][m][n][j] * s;
                    u32x4 w;
                    if (KIND == 0) {
#pragma unroll
                        for (int e = 0; e < 8; ++e) z[e] = siluf_(z[e]);
                        w.x = cvt_pk_bf16(z[0], z[1]); w.y = cvt_pk_bf16(z[2], z[3]); w.z = cvt_pk_bf16(z[4], z[5]); w.w = cvt_pk_bf16(z[6], z[7]);
                        *(u32x4*)(q + rp * 512 + u.pn * 256 + bj * 128 + cw) = w;
                    } else if (KIND == 1) {
                        const int c = (u.pn - 2) * 256 + bj * 128 + cw;
                        unsigned short hh[8];
#pragma unroll
                        for (int e = 0; e < 8; ++e) { const float lb = lbr[bj][e >> 2][e & 3]; const float f = lb + (1.0f - lb) * sigmoidf_(z[e]); hh[e] = f2h(f); }
                        w.x = hh[0] | ((unsigned)hh[1] << 16); w.y = hh[2] | ((unsigned)hh[3] << 16); w.z = hh[4] | ((unsigned)hh[5] << 16); w.w = hh[6] | ((unsigned)hh[7] << 16);
                        *(u32x4*)(lfo + rp * 1024 + c) = w;
                    } else {
                        w.x = cvt_pk_bf16(z[0], z[1]); w.y = cvt_pk_bf16(z[2], z[3]); w.z = cvt_pk_bf16(z[4], z[5]); w.w = cvt_pk_bf16(z[6], z[7]);
                        *(u32x4*)(v + rp * 512 + (u.pn - 6) * 256 + bj * 128 + cw) = w;
                    }
                }
            }
    }
    __device__ __forceinline__ void operator()(const Acc& acc, const Unit& u, int wr, int wc, int fr, int fq) const {
        if (u.pn < 2) run<0>(acc, u, wr, wc, fr, fq); else if (u.pn < 6) run<1>(acc, u, wr, wc, fr, fq); else run<2>(acc, u, wr, wc, fr, fq);
    }
};
struct EpiZb {
    bf16_t* gate; bf16_t* glu; const float* ss;
    __device__ __forceinline__ void operator()(const Acc& acc, const Unit& u, int wr, int wc, int fr, int fq) const {
        if (u.pn >= 2) { EpiPair<1> e{glu, 512, 2, ss, 1}; e(acc, u, wr, wc, fr, fq); return; }
        const int cw = wc * 32 + fq * 8;
        const int rbase = u.pm * 256 + wr * 64 + fr;
        float sv[8];
#pragma unroll
        for (int qq = 0; qq < 8; ++qq) sv[qq] = ss[rbase + (qq >> 2) * 128 + (qq & 3) * 16];
#pragma unroll
        for (int ai = 0; ai < 2; ++ai)
#pragma unroll
            for (int m = 0; m < 4; ++m) {
                const int r = rbase + ai * 128 + m * 16;
                const float s = __builtin_amdgcn_rsqf(sv[ai * 4 + m] * (1.0f / 1024.0f) + RMS_EPS);
#pragma unroll
                for (int bj = 0; bj < 2; ++bj) {
                    float z[8];
#pragma unroll
                    for (int n = 0; n < 2; ++n)
#pragma unroll
                        for (int j = 0; j < 4; ++j) z[n * 4 + j] = siluf_(acc[ai][bj][m][n][j] * s);
                    u32x4 w; w.x = cvt_pk_bf16(z[0], z[1]); w.y = cvt_pk_bf16(z[2], z[3]); w.z = cvt_pk_bf16(z[4], z[5]); w.w = cvt_pk_bf16(z[6], z[7]);
                    *(u32x4*)(gate + (size_t)pad_row(r) * 512 + u.pn * 256 + bj * 128 + cw) = w;
                }
            }
    }
};

struct EpiZ {
    EpiZa a; EpiZb b;
    __device__ __forceinline__ void operator()(const Acc& acc, const Unit& u, int wr, int wc, int fr, int fq) const {
        if (u.pn < 8) a(acc, u, wr, wc, fr, fq); else { const Unit u2{u.pm, u.pn - 8}; b(acc, u2, wr, wc, fr, fq); }
    }
};

template <int STAGE, int NC> __device__ __forceinline__ void meta_stage(LAS unsigned char* lds, const Params& p, int blk) {
    unsigned char* ws = p.ws;
    float* hidm = (float*)(ws + OFF_META);
    float* h1m = (float*)(ws + OFF_META + 196608);
    constexpr int NKS = 512 / NC;
    constexpr int NPL = 2560 / NC;
    const int t = threadIdx.x, col = t % NC, ks = t / NC, lane = t & 63, wave = t >> 6;
    LAS float* red = (LAS float*)lds;
    LAS float* rsl = (LAS float*)(lds + 65536);
    constexpr int K = STAGE == 2 ? 2816 : 1024;
    const float* A = STAGE == 1 ? p.in[2] : (STAGE == 2 ? hidm : h1m);
    const float* gain = STAGE == 1 ? p.in[3] : (STAGE == 3 ? p.in[7] : nullptr);
    const bool pair = (STAGE == 1) || (STAGE == 3 && blk >= NPL);
    const float* W0; const float* W1 = nullptr; int ldw;
    if (STAGE == 1) { W0 = p.in[4] + blk * NC; W1 = p.in[5] + blk * NC; ldw = FF; }
    else if (STAGE == 2) { W0 = p.in[6] + blk * NC; ldw = 1024; }
    else { ldw = 3584; if (blk < NPL) W0 = p.in[8] + blk * NC; else { W0 = p.in[8] + 2560 + (blk - NPL) * NC; W1 = p.in[8] + 3072 + (blk - NPL) * NC; } }
    if (STAGE != 2) {
#pragma unroll
        for (int q = 0; q < 2; ++q) { const int m = wave * 2 + q; float sq = 0.f;
            for (int k = lane; k < 1024; k += 64) { const float a = A[m * 1024 + k]; sq += a * a; }
#pragma unroll
            for (int o = 32; o >= 1; o >>= 1) sq += __shfl_xor(sq, o);
            if (lane == 0) rsl[m] = __builtin_amdgcn_rsqf(sq * (1.0f / 1024.0f) + RMS_EPS); }
    }
    float a0[16], a1[16];
#pragma unroll
    for (int m = 0; m < 16; ++m) { a0[m] = 0.f; a1[m] = 0.f; }
    const int kb = ks * (K / NKS);
    for (int k = kb; k < kb + K / NKS; k += 4) {
        f32x4 av[16];
#pragma unroll
        for (int m = 0; m < 16; ++m) av[m] = *(const f32x4*)(A + (size_t)m * K + k);
#pragma unroll
        for (int e = 0; e < 4; ++e) {
            const float g = gain ? gain[k + e] : 1.0f;
            const float w0 = W0[(size_t)(k + e) * ldw + col] * g;
            const float w1 = pair ? W1[(size_t)(k + e) * ldw + col] * g : 0.f;
#pragma unroll
            for (int m = 0; m < 16; ++m) { a0[m] += av[m][e] * w0; a1[m] += av[m][e] * w1; }
        }
    }
#pragma unroll
    for (int m = 0; m < 16; ++m) { red[(ks * NC + col) * 32 + m] = a0[m]; red[(ks * NC + col) * 32 + 16 + m] = a1[m]; }
    __syncthreads();
    if (t < 16 * NC) { const int m = t / NC;
      float s0 = 0.f, s1 = 0.f;
#pragma unroll 8
      for (int q = 0; q < NKS; ++q) { s0 += red[(q * NC + col) * 32 + m]; s1 += red[(q * NC + col) * 32 + 16 + m]; }
      if (STAGE == 1) { const float rs = rsl[m]; hidm[m * 2816 + blk * NC + col] = siluf_(s0 * rs) * (s1 * rs); }
      else if (STAGE == 2) { const int n = blk * NC + col; h1m[m * 1024 + n] = p.in[2][m * 1024 + n] + 0.5f * s0; }
      else {
          const float rs = rsl[m]; const float z0 = s0 * rs, z1 = s1 * rs;
          bf16_t* qb = (bf16_t*)(ws + OFF_Y + Y_Q); bf16_t* vb = (bf16_t*)(ws + OFF_Y + Y_V); unsigned short* lfo = (unsigned short*)(ws + OFF_Y + Y_LFO);
          bf16_t* gateb = (bf16_t*)p.out + (size_t)R * 1024; bf16_t* glub = (bf16_t*)(ws + OFF_Y + Y_GLU);
          unsigned short* dstp; size_t ld; int c; unsigned short val, padval = 0;
          if (blk >= NPL) { c = (blk - NPL) * NC + col; dstp = glub; ld = 512; val = (unsigned short)(cvt_pk_bf16(z0 * sigmoidf_(z1), 0.f) & 0xffff); }
          else { const int cz = blk * NC + col;
              if (cz < 512) { c = cz; dstp = qb; ld = 512; val = (unsigned short)(cvt_pk_bf16(siluf_(z0), 0.f) & 0xffff); }
              else if (cz < 1536) { c = cz - 512; dstp = lfo; ld = 1024; const float lb = ((const float*)(ws + OFF_LB))[c]; val = f2h(lb + (1.0f - lb) * sigmoidf_(z0)); padval = f2h(1.0f); }
              else if (cz < 2048) { c = cz - 1536; dstp = vb; ld = 512; val = (unsigned short)(cvt_pk_bf16(z0, 0.f) & 0xffff); }
              else { c = cz - 2048; dstp = gateb; ld = 512; val = (unsigned short)(cvt_pk_bf16(siluf_(z0), 0.f) & 0xffff); } }
          for (int sq_ = 0; sq_ < 40; ++sq_) { const size_t base = sq_ < 32 ? (size_t)sq_ * LP : (size_t)RP + (size_t)(sq_ - 32) * LS;
              dstp[(base + 16 + m) * ld + c] = val;
              dstp[(base + m) * ld + c] = padval; }
      }
    }
    __syncthreads();
}

__device__ __forceinline__ void cvt_tile(LAS float* tile, const float* s0, const float* s1, int ld, int mode, const float* gain, bf16_t* dst, int K, int kt, int ntile) {
    const int t = threadIdx.x;
    const int n0 = ntile * 64, k0 = kt * 64;
    const float* src; int col0;
    if (mode == 0) { src = s0; col0 = n0; } else { const int pn = n0 >> 8, w = n0 & 255; src = w < 128 ? s0 : s1; col0 = pn * 128 + (w & 127); }
#pragma unroll
    for (int p = 0; p < 2; ++p) {
        const int kk = (t >> 4) + p * 32, c4 = (t & 15) * 4;
        f32x4 v = *(const f32x4*)(src + (size_t)(k0 + kk) * ld + col0 + c4);
        const float g = gain ? gain[k0 + kk] : 1.0f;
#pragma unroll
        for (int e = 0; e < 4; ++e) tile[kk * 65 + c4 + e] = v[e] * g;
    }
    __syncthreads();
    { const int n = t >> 3, k8 = (t & 7) * 8; float x[8];
#pragma unroll
      for (int j = 0; j < 8; ++j) x[j] = tile[(k8 + j) * 65 + n];
      u32x4 w; w.x = cvt_pk_bf16(x[0], x[1]); w.y = cvt_pk_bf16(x[2], x[3]); w.z = cvt_pk_bf16(x[4], x[5]); w.w = cvt_pk_bf16(x[6], x[7]);
      *(u32x4*)(dst + (size_t)(n0 + n) * K + k0 + k8) = w; }
    __syncthreads();
}
__device__ __forceinline__ void phase_prep(LAS unsigned char* lds, const Params& p) {
    unsigned char* ws = p.ws;
    LAS float* tile = (LAS float*)lds;
    const int J1 = 16 * 88, J2 = 44 * 16, J3A = 16 * 32, J3B = 16 * 24, J4 = 16 * 16;
    const int total = J1 + J2 + J3A + J3B + J4 + J1 + J2;
    for (int job = blockIdx.x; job < total; job += gridDim.x) {
        int j = job;
        const float* s0; const float* s1 = nullptr; const float* gain = nullptr; int ld, mode = 0, K, kt, nt_; bf16_t* dst;
        if (j < J1) { s0 = p.in[4]; s1 = p.in[5]; ld = FF; mode = 1; gain = p.in[3]; dst = (bf16_t*)(ws + OFF_W1); K = 1024; kt = j % 16; nt_ = j / 16; }
        else if ((j -= J1) < J2) { s0 = p.in[6]; ld = 1024; dst = (bf16_t*)(ws + OFF_W2); K = FF; kt = j % 44; nt_ = j / 44; }
        else if ((j -= J2) < J3A) { s0 = p.in[8]; ld = 3584; gain = p.in[7]; dst = (bf16_t*)(ws + OFF_W3A); K = 1024; kt = j % 16; nt_ = j / 16; }
        else if ((j -= J3A) < J3B) { ld = 3584; gain = p.in[7]; K = 1024; kt = j % 16; nt_ = j / 16;
            if (nt_ < 8) { s0 = p.in[8] + 2048; dst = (bf16_t*)(ws + OFF_W3B); }
            else { s0 = p.in[8] + 2560; s1 = p.in[8] + 3072; mode = 1; dst = (bf16_t*)(ws + OFF_W3B) + (size_t)512 * 1024; nt_ -= 8; } }
        else if ((j -= J3B) < J4) { s0 = p.in[15]; ld = 1024; dst = (bf16_t*)(ws + OFF_W4); K = 1024; kt = j % 16; nt_ = j / 16; }
        else if ((j -= J4) < J1) { s0 = p.in[17]; s1 = p.in[18]; ld = FF; mode = 1; gain = p.in[16]; dst = (bf16_t*)(ws + OFF_W5); K = 1024; kt = j % 16; nt_ = j / 16; }
        else { j -= J1; s0 = p.in[19]; ld = 1024; dst = (bf16_t*)(ws + OFF_W6); K = FF; kt = j % 44; nt_ = j / 44; }
        cvt_tile(tile, s0, s1, ld, mode, gain, dst, K, kt, nt_);
    }
    if (blockIdx.x == 0) for (int i = threadIdx.x; i < 1024; i += NTHREADS) { const float l0 = p.in[9][i], l1 = p.in[9][1024 + i]; ((float*)(ws + OFF_LB))[i] = 1.0f / (1.0f + __expf(l1 - l0)); }
    float* ss = (float*)(ws + OFF_SS);
    bf16_t* hb = (bf16_t*)(ws + OFF_X);
    const int wave = threadIdx.x >> 6, lane = threadIdx.x & 63;
    for (int r0 = (blockIdx.x * 8 + wave) * 4; r0 < NRC; r0 += gridDim.x * 32) {
        f32x4 v[4][4];
#pragma unroll
        for (int q = 0; q < 4; ++q) {
            const long orow = r0 + q;
            const float* src = orow < 65536 ? p.in[0] + orow * 1024 : p.in[1] + (orow - 65536) * 1024;
#pragma unroll
            for (int j = 0; j < 4; ++j) v[q][j] = *(const f32x4*)(src + j * 256 + lane * 4);
        }
#pragma unroll
        for (int q = 0; q < 4; ++q) {
            const int r = r0 + q; float sq = 0.f;
#pragma unroll
            for (int j = 0; j < 4; ++j) {
                const f32x4 x = v[q][j];
                sq += (x[0] * x[0] + x[1] * x[1]) + (x[2] * x[2] + x[3] * x[3]);
                u32x2 w; w.x = cvt_pk_bf16(x[0], x[1]); w.y = cvt_pk_bf16(x[2], x[3]);
                *(u32x2*)(hb + (size_t)r * 1024 + j * 256 + lane * 4) = w;
            }
#pragma unroll
            for (int o = 32; o >= 1; o >>= 1) sq += __shfl_xor(sq, o);
            if (lane == 0) { ss[r] = sq; ss[R + r] = 0.f; ss[2 * R + r] = 0.f; ss[3 * R + r] = 0.f; }
        }
    }
    if (blockIdx.x < 176) meta_stage<1, 16>(lds, p, blockIdx.x);
}

constexpr int SC_QT = 0, SC_KT = 8704, SC_KTT = 17408, SC_VT = 27648, SC_E1 = 32768, SC_E2 = 33280, SC_BUF = 33792;
struct ScanJob { int nch, rb, dir; size_t fcol, qcol, vcol; };
__device__ __forceinline__ size_t scan_row(const ScanJob& J, int c, int i) { return (size_t)J.rb + c * 32 + (J.dir ? 31 - i : i); }
__device__ __forceinline__ void scan_load(const ScanJob& J, int cidx, const unsigned short* lfo, const bf16_t* qb, const bf16_t* vb, int tp,
                                          unsigned short (&fr_)[16], unsigned short (&qr_)[16], unsigned short (&vr_)[8]) {
    if (cidx >= J.nch) return;
    const int c = J.dir ? J.nch - 1 - cidx : cidx;
    const int ch = tp & 127, seg = tp >> 7, vch = tp & 63, vseg = tp >> 6;
#pragma unroll
    for (int j = 0; j < 16; ++j) { const size_t r = scan_row(J, c, seg * 16 + j); fr_[j] = lfo[r * 1024 + J.fcol + ch]; qr_[j] = qb[r * 512 + J.qcol + ch]; }
#pragma unroll
    for (int j = 0; j < 8; ++j) { const size_t r = scan_row(J, c, vseg * 8 + j); vr_[j] = vb[r * 512 + J.vcol + vch]; }
}
__device__ __forceinline__ void scan_prep(LAS unsigned char* lds, const ScanJob& J, int cidx, const unsigned short* lfo, const bf16_t* qb, const bf16_t* vb, int tp,
                                          unsigned short (&fr_)[16], unsigned short (&qr_)[16], unsigned short (&vr_)[8]) {
    LAS unsigned char* B = lds + (cidx & 1) * SC_BUF;
    const int ch = tp & 127, seg = tp >> 7, vch = tp & 63, vseg = tp >> 6;
    float tot = 1.0f;
#pragma unroll
    for (int j = 0; j < 16; ++j) tot *= h2f(fr_[j]);
    const float sc = seg == 0 ? 1.0f / tot : 1.0f;
    unsigned short kt16[16];
    float run = sc;
#pragma unroll
    for (int j = 0; j < 16; ++j) {
        const float f = h2f(fr_[j]);
        run *= f;
        const float E = run, Ri = __builtin_amdgcn_rcpf(E);
        const unsigned pk = cvt_pk_bf16(bf2f(qr_[j]) * E, (1.0f - f) * Ri);
        const int i = seg * 16 + j;
        *(LAS unsigned short*)(B + SC_QT + i * 272 + ch * 2) = (unsigned short)(pk & 0xffff);
        *(LAS unsigned short*)(B + SC_KT + i * 272 + ch * 2) = (unsigned short)(pk >> 16);
        kt16[j] = (unsigned short)(pk >> 16);
    }
    { u32x4 w0, w1;
      w0.x = kt16[0] | ((unsigned)kt16[1] << 16); w0.y = kt16[2] | ((unsigned)kt16[3] << 16); w0.z = kt16[4] | ((unsigned)kt16[5] << 16); w0.w = kt16[6] | ((unsigned)kt16[7] << 16);
      w1.x = kt16[8] | ((unsigned)kt16[9] << 16); w1.y = kt16[10] | ((unsigned)kt16[11] << 16); w1.z = kt16[12] | ((unsigned)kt16[13] << 16); w1.w = kt16[14] | ((unsigned)kt16[15] << 16);
      *(LAS u32x4*)(B + SC_KTT + ch * 80 + seg * 32) = w0; *(LAS u32x4*)(B + SC_KTT + ch * 80 + seg * 32 + 16) = w1;
      u32x4 wv; wv.x = vr_[0] | ((unsigned)vr_[1] << 16); wv.y = vr_[2] | ((unsigned)vr_[3] << 16); wv.z = vr_[4] | ((unsigned)vr_[5] << 16); wv.w = vr_[6] | ((unsigned)vr_[7] << 16);
      *(LAS u32x4*)(B + SC_VT + vch * 80 + vseg * 16) = wv; }
    if (seg == 0) { const float e2p = cidx > 0 ? ((const LAS float*)(lds + ((cidx & 1) ^ 1) * SC_BUF + SC_E2))[ch] : 1.0f; ((LAS float*)(B + SC_E1))[ch] = tot * e2p; }
    else ((LAS float*)(B + SC_E2))[ch] = tot;
    scan_load(J, cidx + 2, lfo, qb, vb, tp, fr_, qr_, vr_);
}
__device__ __forceinline__ void scan_mfma(LAS unsigned char* lds, const ScanJob& J, int cidx, unsigned short* ob, int w, int g, int l15, f32x4 (&S)[8]) {
    LAS unsigned char* B = lds + (cidx & 1) * SC_BUF;
    const int c = J.dir ? J.nch - 1 - cidx : cidx;
#pragma unroll
    for (int kt = 0; kt < 8; ++kt) S[kt] *= *(const LAS f32x4*)(B + SC_E1 + (kt * 16 + g * 4) * 4);
    f32x4 o0 = {0.f, 0.f, 0.f, 0.f}, o1 = o0, c00 = o0, c01 = o0, c11 = o0;
#pragma unroll
    for (int ks = 0; ks < 4; ++ks) {
        bf16x8 Aq[2], Ak[2];
#pragma unroll
        for (int it = 0; it < 2; ++it) {
            const LAS unsigned char* qa = B + SC_QT + (it * 16 + l15) * 272 + (ks * 32 + g * 4) * 2;
            const LAS unsigned char* ka = B + SC_KT + (it * 16 + l15) * 272 + (ks * 32 + g * 4) * 2;
            const u32x2 q0 = *(const LAS u32x2*)qa, q1 = *(const LAS u32x2*)(qa + 32), k0 = *(const LAS u32x2*)ka, k1 = *(const LAS u32x2*)(ka + 32);
            u32x4 qq = {q0.x, q0.y, q1.x, q1.y}, kk = {k0.x, k0.y, k1.x, k1.y};
            Aq[it] = __builtin_bit_cast(bf16x8, qq); Ak[it] = __builtin_bit_cast(bf16x8, kk);
        }
        u32x4 sw; sw.x = cvt_pk_bf16(S[2 * ks][0], S[2 * ks][1]); sw.y = cvt_pk_bf16(S[2 * ks][2], S[2 * ks][3]); sw.z = cvt_pk_bf16(S[2 * ks + 1][0], S[2 * ks + 1][1]); sw.w = cvt_pk_bf16(S[2 * ks + 1][2], S[2 * ks + 1][3]);
        const bf16x8 Sf = __builtin_bit_cast(bf16x8, sw);
        o0 = __builtin_amdgcn_mfma_f32_16x16x32_bf16(Aq[0], Sf, o0, 0, 0, 0);
        o1 = __builtin_amdgcn_mfma_f32_16x16x32_bf16(Aq[1], Sf, o1, 0, 0, 0);
        c00 = __builtin_amdgcn_mfma_f32_16x16x32_bf16(Ak[0], Aq[0], c00, 0, 0, 0);
        c01 = __builtin_amdgcn_mfma_f32_16x16x32_bf16(Ak[0], Aq[1], c01, 0, 0, 0);
        c11 = __builtin_amdgcn_mfma_f32_16x16x32_bf16(Ak[1], Aq[1], c11, 0, 0, 0);
    }
#pragma unroll
    for (int e = 0; e < 4; ++e) { const bool keep = (g * 4 + e) <= l15; c00[e] = keep ? c00[e] : 0.f; c11[e] = keep ? c11[e] : 0.f; }
    { u32x4 pw; pw.x = cvt_pk_bf16(c00[0], c00[1]); pw.y = cvt_pk_bf16(c00[2], c00[3]); pw.z = 0u; pw.w = 0u;
      u32x4 pw1; pw1.x = cvt_pk_bf16(c01[0], c01[1]); pw1.y = cvt_pk_bf16(c01[2], c01[3]); pw1.z = cvt_pk_bf16(c11[0], c11[1]); pw1.w = cvt_pk_bf16(c11[2], c11[3]);
      const LAS unsigned char* va = B + SC_VT + (w * 16 + l15) * 80;
      const u32x2 v0 = *(const LAS u32x2*)(va + g * 8), v1 = *(const LAS u32x2*)(va + 32 + g * 8);
      u32x4 vp = {v0.x, v0.y, v1.x, v1.y};
      const bf16x8 Vp = __builtin_bit_cast(bf16x8, vp);
      o0 = __builtin_amdgcn_mfma_f32_16x16x32_bf16(__builtin_bit_cast(bf16x8, pw), Vp, o0, 0, 0, 0);
      o1 = __builtin_amdgcn_mfma_f32_16x16x32_bf16(__builtin_bit_cast(bf16x8, pw1), Vp, o1, 0, 0, 0);
      const bf16x8 Vn = *(const LAS bf16x8*)(va + g * 16);
#pragma unroll
      for (int kt = 0; kt < 8; ++kt) {
          const bf16x8 Ka = *(const LAS bf16x8*)(B + SC_KTT + (kt * 16 + l15) * 80 + g * 16);
          S[kt] = __builtin_amdgcn_mfma_f32_16x16x32_bf16(Ka, Vn, S[kt], 0, 0, 0);
      }
    }
#pragma unroll
    for (int e = 0; e < 4; ++e) {
        const size_t r0 = scan_row(J, c, g * 4 + e), r1 = scan_row(J, c, 16 + g * 4 + e);
        ob[r0 * 1024 + J.fcol + (J.vcol - J.qcol) + w * 16 + l15] = (unsigned short)(cvt_pk_bf16(o0[e], 0.f) & 0xffff);
        ob[r1 * 1024 + J.fcol + (J.vcol - J.qcol) + w * 16 + l15] = (unsigned short)(cvt_pk_bf16(o1[e], 0.f) & 0xffff);
    }
}
__device__ __forceinline__ void scan_job(LAS unsigned char* lds, const Params& p, int hj) {
    unsigned char* ws = p.ws;
    const bf16_t* qb = (const bf16_t*)(ws + OFF_Y + Y_Q);
    const bf16_t* vb = (const bf16_t*)(ws + OFF_Y + Y_V);
    const unsigned short* lfo = (const unsigned short*)(ws + OFF_Y + Y_LFO);
    unsigned short* ob = (unsigned short*)p.out;
    int seq;
    if (hj < 128) seq = 32 + (hj >> 4); else { hj -= 128; seq = hj >> 4; }
    const int head = (hj >> 2) & 3, dir = (hj >> 1) & 1, dvh = hj & 1;
    ScanJob J;
    J.nch = seq < 32 ? LP / 32 : LS / 32; J.rb = seq < 32 ? seq * LP : RP + (seq - 32) * LS; J.dir = dir;
    J.fcol = (size_t)dir * 512 + head * 128; J.qcol = (size_t)head * 128; J.vcol = J.qcol + dvh * 64;
    const int t = threadIdx.x, lane = t & 63, w = __builtin_amdgcn_readfirstlane(t >> 6), g = lane >> 4, l15 = lane & 15;
    const bool prep = w >= 4;
    const int tp = t & 255;
    if (prep) {
        unsigned short fA[16], qA[16], vA[8], fB[16], qB[16], vB[8];
        scan_load(J, 0, lfo, qb, vb, tp, fA, qA, vA); scan_load(J, 1, lfo, qb, vb, tp, fB, qB, vB);
        for (int k = 0; k <= J.nch; k += 2) {
            if (k < J.nch) scan_prep(lds, J, k, lfo, qb, vb, tp, fA, qA, vA);
            __syncthreads();
            if (k + 1 <= J.nch) {
                if (k + 1 < J.nch) scan_prep(lds, J, k + 1, lfo, qb, vb, tp, fB, qB, vB);
                __syncthreads();
            }
        }
    } else {
        f32x4 S[8];
#pragma unroll
        for (int k = 0; k < 8; ++k) S[k] = (f32x4){0.f, 0.f, 0.f, 0.f};
        __builtin_amdgcn_s_setprio(2);
        __syncthreads();
        for (int cc = 0; cc < J.nch; ++cc) {
            scan_mfma(lds, J, cc, ob, w, g, l15, S);
            __syncthreads();
        }
        __builtin_amdgcn_s_setprio(0);
    }
}
__device__ __forceinline__ void phase_scan(LAS unsigned char* lds, const Params& p) {
    const int b = blockIdx.x;
    const bool stdg = gridDim.x == 256;
    const int x = b & 7, i16 = (b >> 3) & 15;
    const int slot = ((i16 >> 1) * 8 + x) * 2 + (i16 & 1);
    for (int it = 0;; ++it) {
        int job;
        if (stdg) { if (b < 128) { if (it) break; job = slot; } else { if (it >= 4) break; job = 128 + slot + 128 * it; } }
        else { job = b + it * (int)gridDim.x; if (job >= 640) break; }
        scan_job(lds, p, job);
    }
}

__device__ __forceinline__ void phase_mix(LAS unsigned char* lds, const Params& p) {
    unsigned char* ws = p.ws;
    const bf16_t* gate = (const bf16_t*)p.out + (size_t)R * 1024;
    const bf16_t* glu = (const bf16_t*)(ws + OFF_Y + Y_GLU);
    bf16_t* mix = (bf16_t*)(ws + OFF_Y + Y_LFO);
    const bf16_t* osc = (const bf16_t*)p.out;
    const int t = threadIdx.x, lane = t & 63, w = t >> 6;
    float cw[31];
#pragma unroll
    for (int j = 0; j < 31; ++j) cw[j] = p.in[11][j * 512 + t];
    const float cb = p.in[12][t];
    LAS float* tile = (LAS float*)lds;
    float lg[8], lb_[8], hn[8];
#pragma unroll
    for (int e = 0; e < 8; ++e) { lg[e] = p.in[13][lane * 8 + e]; lb_[e] = p.in[14][lane * 8 + e]; hn[e] = p.in[10][lane * 8 + e]; }
    for (int tix = blockIdx.x; tix < 2048; tix += gridDim.x) {
        int r0; size_t o0;
        if (tix < 1024) { const int sq_ = tix >> 5, k = tix & 31; r0 = sq_ * LP + 32 + 64 * k; o0 = (size_t)sq_ * 2048 + 64 * k; }
        else { const int tt = tix - 1024, q_ = tt >> 7, k = tt & 127; r0 = RP + q_ * LS + 32 + 64 * k; o0 = (size_t)65536 + (size_t)q_ * 8192 + 64 * k; }
        unsigned short xr[94];
#pragma unroll
        for (int i = 0; i < 94; ++i) { int r = r0 - 15 + i; r = r >= R ? R - 1 : r; xr[i] = glu[(size_t)r * 512 + t]; }
        float x[94];
#pragma unroll
        for (int i = 0; i < 94; ++i) { const int r = r0 - 15 + i; x[i] = r < R ? bf2f(xr[i]) : 0.f; }
#pragma unroll
        for (int i = 0; i < 64; ++i) { float a = cb;
#pragma unroll
            for (int j = 0; j < 31; ++j) a += cw[j] * x[i + j];
            tile[i * 512 + t] = a; }
        u32x4 ca[8], cbv[8], cg[8];
#pragma unroll
        for (int rr = 0; rr < 8; ++rr) { const size_t r = (size_t)r0 + w * 8 + rr;
            ca[rr] = *(const u32x4*)(osc + r * 1024 + lane * 8); cbv[rr] = *(const u32x4*)(osc + r * 1024 + 512 + lane * 8); cg[rr] = *(const u32x4*)(gate + r * 512 + lane * 8); }
        __syncthreads();
#pragma unroll
        for (int rr = 0; rr < 8; ++rr) {
            const int i = w * 8 + rr;
            { const u32x4 a = ca[rr], b = cbv[rr], gt = cg[rr];
              float o[8] = {bflo(a.x) + bflo(b.x), bfhi(a.x) + bfhi(b.x), bflo(a.y) + bflo(b.y), bfhi(a.y) + bfhi(b.y), bflo(a.z) + bflo(b.z), bfhi(a.z) + bfhi(b.z), bflo(a.w) + bflo(b.w), bfhi(a.w) + bfhi(b.w)};
              const float gg[8] = {bflo(gt.x), bfhi(gt.x), bflo(gt.y), bfhi(gt.y), bflo(gt.z), bfhi(gt.z), bflo(gt.w), bfhi(gt.w)};
              float sq = 0.f;
#pragma unroll
              for (int e = 0; e < 8; ++e) sq += o[e] * o[e];
              sq += __shfl_xor(sq, 1); sq += __shfl_xor(sq, 2); sq += __shfl_xor(sq, 4); sq += __shfl_xor(sq, 8);
              const float rs = __builtin_amdgcn_rsqf(sq * (1.0f / 128.0f) + RMS_EPS);
#pragma unroll
              for (int e = 0; e < 8; ++e) o[e] = o[e] * rs * hn[e] * gg[e];
              u32x4 wv; wv.x = cvt_pk_bf16(o[0], o[1]); wv.y = cvt_pk_bf16(o[2], o[3]); wv.z = cvt_pk_bf16(o[4], o[5]); wv.w = cvt_pk_bf16(o[6], o[7]);
              *(u32x4*)(mix + (o0 + i) * 1024 + lane * 8) = wv; }
            { const f32x4 y0 = *(const LAS f32x4*)(tile + i * 512 + lane * 8), y1 = *(const LAS f32x4*)(tile + i * 512 + lane * 8 + 4);
              float y[8] = {y0[0], y0[1], y0[2], y0[3], y1[0], y1[1], y1[2], y1[3]};
              float s = 0.f;
#pragma unroll
              for (int e = 0; e < 8; ++e) s += y[e];
#pragma unroll
              for (int o = 32; o >= 1; o >>= 1) s += __shfl_xor(s, o);
              const float mu = s * (1.0f / 512.0f); float q = 0.f;
#pragma unroll
              for (int e = 0; e < 8; ++e) { y[e] -= mu; q += y[e] * y[e]; }
#pragma unroll
              for (int o = 32; o >= 1; o >>= 1) q += __shfl_xor(q, o);
              const float rs = __builtin_amdgcn_rsqf(q * (1.0f / 512.0f) + LN_EPS);
#pragma unroll
              for (int e = 0; e < 8; ++e) y[e] = siluf_(y[e] * rs * lg[e] + lb_[e]);
              u32x4 wv; wv.x = cvt_pk_bf16(y[0], y[1]); wv.y = cvt_pk_bf16(y[2], y[3]); wv.z = cvt_pk_bf16(y[4], y[5]); wv.w = cvt_pk_bf16(y[6], y[7]);
              *(u32x4*)(mix + (o0 + i) * 1024 + 512 + lane * 8) = wv; }
        }
        __syncthreads();
    }
}

__device__ __forceinline__ void phase_final(const Params& p) {
    const float* ss3 = (const float*)(p.ws + OFF_SS) + 3 * (size_t)R;
    const bf16_t* hb = (const bf16_t*)(p.ws + OFF_X);
    const int wave = threadIdx.x >> 6, lane = threadIdx.x & 63;
    f32x4 g[4];
#pragma unroll
    for (int j = 0; j < 4; ++j) g[j] = *(const f32x4*)(p.in[20] + j * 256 + lane * 4);
    for (int r0 = (blockIdx.x * 8 + wave) * 4; r0 < NRC; r0 += gridDim.x * 32) {
        u32x2 h[4][4]; float sv[4];
#pragma unroll
        for (int q = 0; q < 4; ++q) { sv[q] = ss3[r0 + q];
#pragma unroll
            for (int j = 0; j < 4; ++j) h[q][j] = *(const u32x2*)(hb + (size_t)(r0 + q) * 1024 + j * 256 + lane * 4); }
#pragma unroll
        for (int q = 0; q < 4; ++q) {
            float* op = p.out + (size_t)(r0 + q) * 1024;
            const float s = __builtin_amdgcn_rsqf(sv[q] * (1.0f / 1024.0f) + RMS_EPS);
#pragma unroll
            for (int j = 0; j < 4; ++j) { f32x4 x = {bflo(h[q][j].x), bfhi(h[q][j].x), bflo(h[q][j].y), bfhi(h[q][j].y)}; x = x * s * g[j]; *(f32x4*)(op + j * 256 + lane * 4) = x; }
        }
    }
}

#define XB_TMO      128
#define XB_XCNT(j)  (256  + 64 * (j))
#define XB_XSUB(j)  (1280 + 64 * (j))
#define XB_XGEN(j)  (2304 + 64 * (j))
#define XB_TOP      3328
#define XB_TOPGEN   3392
#define XCD_BAR_WORDS 3456
#define XB_SPIN_CAP (1u << 20)
__device__ __forceinline__ unsigned xb_ld(unsigned* p)              { return __hip_atomic_load(p, __ATOMIC_RELAXED, __HIP_MEMORY_SCOPE_AGENT); }
__device__ __forceinline__ unsigned xb_add(unsigned* p, unsigned v) { return __hip_atomic_fetch_add(p, v, __ATOMIC_RELAXED, __HIP_MEMORY_SCOPE_AGENT); }
__device__ __forceinline__ unsigned xb_xcc_id() { return (unsigned)__builtin_amdgcn_s_getreg((3 << 11) | 20) & 0xFu; }
#define XB_SPIN(cond, bar) do { unsigned _sp = 0; while (cond) { __builtin_amdgcn_s_sleep(1); \
    if ((++_sp & 255u) == 0u) { if (xb_ld(&(bar)[XB_TMO])) break; if (_sp > XB_SPIN_CAP) { atomicAdd(&(bar)[XB_TMO], 1u); break; } } } } while (0)
struct XcdBarrier { unsigned* bar; unsigned x; volatile LAS unsigned* st; };
__device__ __forceinline__ XcdBarrier xcd_barrier_post(unsigned* bar, volatile LAS unsigned* st) {
    XcdBarrier b; b.bar = bar; b.x = xb_xcc_id(); b.st = st;
    if (threadIdx.x == 0) (void)xb_add(&bar[XB_XCNT(b.x)], 1u);
    return b;
}
__device__ __forceinline__ void xcd_barrier_complete(unsigned* bar, unsigned x, unsigned& nloc, unsigned& nx) {
    const unsigned G = gridDim.x * gridDim.y * gridDim.z;
    unsigned sum, cnt, mine, sp = 0u;
    for (;;) {
        sum = 0u; cnt = 0u; mine = 0u;
#pragma unroll
        for (unsigned j = 0; j < 16; ++j) { const unsigned c = xb_ld(&bar[XB_XCNT(j)]); sum += c; cnt += (c > 0u) ? 1u : 0u; mine = (j == x) ? c : mine; }
        if (sum == G) break;
        __builtin_amdgcn_s_sleep(1);
        if ((++sp & 255u) == 0u) { if (xb_ld(&bar[XB_TMO])) break; if (sp > XB_SPIN_CAP) { atomicAdd(&bar[XB_TMO], 1u); break; } }
    }
    nloc = mine > 0u ? mine : 1u; nx = cnt > 0u ? cnt : 1u;
}
__device__ __forceinline__ void xcd_barrier(const XcdBarrier& b) {
    asm volatile("s_waitcnt vmcnt(0)" ::: "memory");
    __syncthreads();
    if (threadIdx.x == 0) {
        unsigned* bar = b.bar;
        __builtin_amdgcn_s_waitcnt(0);
        unsigned nloc = b.st[0], nx = b.st[1];
        if (nloc == 0u) { xcd_barrier_complete(bar, b.x, nloc, nx); b.st[0] = nloc; b.st[1] = nx; }
        const unsigned old = xb_add(&bar[XB_XSUB(b.x)], 1u);
        const unsigned gen = old / nloc;
        if (old + 1u == (gen + 1u) * nloc) {
            __builtin_amdgcn_fence(__ATOMIC_RELEASE, "agent");
            asm volatile("s_waitcnt vmcnt(0)" ::: "memory");
            const unsigned og = xb_add(&bar[XB_TOP], 1u);
            const unsigned tg = og / nx;
            if (og + 1u == (tg + 1u) * nx) xb_add(&bar[XB_TOPGEN], 1u);
            else XB_SPIN(xb_ld(&bar[XB_TOPGEN]) == tg, bar);
            __builtin_amdgcn_fence(__ATOMIC_ACQUIRE, "agent");
            xb_add(&bar[XB_XGEN(b.x)], 1u);
            asm volatile("s_waitcnt vmcnt(0)" ::: "memory");
        } else {
            XB_SPIN(xb_ld(&bar[XB_XGEN(b.x)]) == gen, bar);
            __builtin_amdgcn_fence(__ATOMIC_ACQUIRE, "agent");
            asm volatile("s_waitcnt vmcnt(0)" ::: "memory");
        }
    }
    __syncthreads();
}

__global__ void __launch_bounds__(NTHREADS, 2) hymba_fwd(Params p) {
    extern __shared__ __attribute__((aligned(16))) unsigned char lds_raw[];
    LAS unsigned char* lds = (LAS unsigned char*)lds_raw;
    unsigned char* ws = p.ws;
    float* ss = (float*)(ws + OFF_SS);
    bf16_t* hb = (bf16_t*)(ws + OFF_X);
    bf16_t* Y = (bf16_t*)(ws + OFF_Y);
    const int lo = p.ph_lo, hi = p.ph_hi;
#if COOP
    volatile LAS unsigned* xst = (volatile LAS unsigned*)(lds + 131072);
    if (threadIdx.x == 0) { xst[0] = 0u; xst[1] = 0u; }
    __syncthreads();
    const XcdBarrier xbar = xcd_barrier_post((unsigned*)(ws + OFF_BAR), xst);
#endif
#define IN(k) (lo <= (k) && (k) < hi)
#ifdef PROBE_MASK
    unsigned long long tph = __builtin_amdgcn_s_memrealtime();
#define PROBE(k) do { if ((PROBE_MASK >> (k)) & 1) { const unsigned long long t1 = __builtin_amdgcn_s_memrealtime(); while (__builtin_amdgcn_s_memrealtime() - t1 < t1 - tph) __builtin_amdgcn_s_sleep(8); } tph = __builtin_amdgcn_s_memrealtime(); } while (0)
#else
#define PROBE(k) do { } while (0)
#endif
#if COOP
#define SEAM(k) do { if (IN(k) && IN((k) + 1)) xcd_barrier(xbar); PROBE(k); } while (0)
#else
#define SEAM(k) do { } while (0)
#endif
    if (lo < 0) cg::this_grid().sync();
    if (IN(0)) phase_prep(lds, p);
    SEAM(0);
    if (IN(1)) { if (blockIdx.x < 128) meta_stage<2, 8>(lds, p, blockIdx.x);
        EpiPair<0> E{Y, FF, 0, ss, 0}; pg8::gemm_phase(lds, hb, (const bf16_t*)(ws + OFF_W1), NRC, 5632, 1024, E, STAG); }
    SEAM(1);
    if (IN(2)) { EpiRes<0> E{hb, hb, ss + R}; pg8::gemm_phase(lds, Y, (const bf16_t*)(ws + OFF_W2), NRC, 1024, FF, E); }
    SEAM(2);
    if (IN(3)) { if (blockIdx.x < 192) meta_stage<3, 16>(lds, p, blockIdx.x);
        EpiZ E{EpiZa{(bf16_t*)(ws + OFF_Y + Y_Q), (bf16_t*)(ws + OFF_Y + Y_V), (unsigned short*)(ws + OFF_Y + Y_LFO), ss + R, (const float*)(ws + OFF_LB)},
                        EpiZb{(bf16_t*)p.out + (size_t)R * 1024, (bf16_t*)(ws + OFF_Y + Y_GLU), ss + R}};
        pg8::gemm_phase(lds, hb, (const bf16_t*)(ws + OFF_W3A), NRC, 3584, 1024, E, STAG); }
    SEAM(3);
    if (IN(4)) phase_scan(lds, p);
    SEAM(4);
    if (IN(6)) phase_mix(lds, p);
    SEAM(6);
    if (IN(7)) { EpiRes<1> E{hb, (bf16_t*)p.out, ss + 2 * R}; pg8::gemm_phase(lds, (const bf16_t*)(ws + OFF_Y + Y_LFO), (const bf16_t*)(ws + OFF_W4), NRC, 1024, 1024, E); }
    SEAM(7);
    if (IN(8)) { EpiPair<0> E{Y, FF, 0, ss + 2 * R, 0}; pg8::gemm_phase(lds, (const bf16_t*)p.out, (const bf16_t*)(ws + OFF_W5), NRC, 5632, 1024, E, STAG); }
    SEAM(8);
    if (IN(9)) { EpiRes<2> E{(const bf16_t*)p.out, hb, ss + 3 * R}; pg8::gemm_phase(lds, Y, (const bf16_t*)(ws + OFF_W6), NRC, 1024, FF, E); }
    SEAM(9);
    if (IN(10)) phase_final(p);
    PROBE(10);
#undef IN
#undef SEAM
}

extern "C" void kernel_launch(void* const* d_in, const int* in_sizes, int n_in, void* d_out, int out_size, void* d_ws, size_t ws_size, hipStream_t stream) {
    constexpr int LDS_BYTES = 131072 + 16;
    static int grid = 0;
    if (grid == 0) {
        if (n_in != 21 || ws_size < WS_END) { fprintf(stderr, "kernel_launch: need 21 inputs and %zu bytes of workspace; got %d, %zu\n", (size_t)WS_END, n_in, ws_size); grid = -1; return; }
        int dev = 0, cus = 0, per_cu = 0;
        (void)hipGetDevice(&dev); (void)hipDeviceGetAttribute(&cus, hipDeviceAttributeMultiprocessorCount, dev);
        if (hipFuncSetAttribute((const void*)hymba_fwd, hipFuncAttributeMaxDynamicSharedMemorySize, LDS_BYTES) != hipSuccess) { fprintf(stderr, "kernel_launch: hipFuncSetAttribute failed\n"); grid = -1; return; }
        if (hipOccupancyMaxActiveBlocksPerMultiprocessor(&per_cu, (const void*)hymba_fwd, NTHREADS, LDS_BYTES) != hipSuccess || per_cu < 1) per_cu = 1;
        (void)hipGetLastError();
        grid = cus * 1;
        if (grid <= 0) grid = 256;
    }
    if (grid < 0) return;
    if (hipMemsetAsync((char*)d_ws + OFF_BAR, 0, XCD_BAR_WORDS * 4, stream) != hipSuccess) { fprintf(stderr, "kernel_launch: memset of the barrier words failed\n"); return; }
    Params p{};
    for (int i = 0; i < 21; ++i) p.in[i] = (const float*)d_in[i];
    p.out = (float*)d_out; p.ws = (unsigned char*)d_ws;
#if COOP
    p.ph_lo = 0; p.ph_hi = 11;
    void* args[] = {&p};
    hipError_t e = hipLaunchCooperativeKernel((const void*)hymba_fwd, dim3(grid), dim3(NTHREADS), args, LDS_BYTES, stream);
    if (e != hipSuccess) fprintf(stderr, "cooperative launch failed: %s (grid %d)\n", hipGetErrorString(e), grid);
#else
    for (int ph = 0; ph < 11; ++ph) { p.ph_lo = ph; p.ph_hi = ph + 1; hipLaunchKernelGGL(hymba_fwd, dim3(grid), dim3(NTHREADS), LDS_BYTES, stream, p); }
#endif
}
```

```cpp
#include <hip/hip_runtime.h>
#include <hip/hip_cooperative_groups.h>
#include <cstdio>
namespace cg = cooperative_groups;

#define LAS __attribute__((address_space(3)))
typedef unsigned short bf16_t;
typedef short bf16x8 __attribute__((ext_vector_type(8)));
typedef float f32x4 __attribute__((ext_vector_type(4)));
typedef unsigned u32x4 __attribute__((ext_vector_type(4)));
typedef unsigned u32x2 __attribute__((ext_vector_type(2)));

#ifndef COOP
#define COOP 1
#endif
#ifndef STAG
#define STAG 0
#endif

constexpr int D = 1024, FF = 2816;
constexpr int LP = 2080, LS = 8224;
constexpr int RP = 32 * LP;
constexpr int R = RP + 8 * LS;
constexpr int NRC = 131072;
constexpr int NTHREADS = 512;
constexpr float RMS_EPS = 1e-6f, LN_EPS = 1e-5f;

constexpr size_t SZ_W1 = (size_t)5632 * 1024 * 2, SZ_W2 = (size_t)1024 * 2816 * 2, SZ_W3A = (size_t)2048 * 1024 * 2, SZ_W3B = (size_t)1536 * 1024 * 2, SZ_W4 = (size_t)1024 * 1024 * 2;
constexpr size_t OFF_W1 = 0, OFF_W2 = OFF_W1 + SZ_W1, OFF_W3A = OFF_W2 + SZ_W2, OFF_W3B = OFF_W3A + SZ_W3A, OFF_W4 = OFF_W3B + SZ_W3B, OFF_W5 = OFF_W4 + SZ_W4, OFF_W6 = OFF_W5 + SZ_W1;
constexpr size_t OFF_SS = OFF_W6 + SZ_W2;
constexpr size_t OFF_LB = OFF_SS + (size_t)4 * R * 4;
constexpr size_t OFF_BAR = OFF_LB + 4096;
constexpr size_t OFF_META = OFF_BAR + 16384;
constexpr size_t OFF_X = OFF_META + 262144;
constexpr size_t OFF_Y = OFF_X + (size_t)R * 1024 * 2;
constexpr size_t WS_END = OFF_Y + (size_t)R * 2816 * 2;
constexpr size_t Y_Q = 0, Y_V = (size_t)R * 1024, Y_LFO = (size_t)2 * R * 1024, Y_GLU = (size_t)4 * R * 1024;

struct Params { const float* in[21]; float* out; unsigned char* ws; int ph_lo, ph_hi; };

typedef __bf16 bf16v2_t __attribute__((ext_vector_type(2)));
typedef float f32x2_t __attribute__((ext_vector_type(2)));
__device__ __forceinline__ unsigned cvt_pk_bf16(float lo, float hi) { const f32x2_t v = {lo, hi}; const bf16v2_t b = __builtin_convertvector(v, bf16v2_t); return __builtin_bit_cast(unsigned, b); }
__device__ __forceinline__ float bf2f(unsigned short b) { return __uint_as_float(((unsigned)b) << 16); }
__device__ __forceinline__ float bflo(unsigned w) { return __uint_as_float(w << 16); }
__device__ __forceinline__ float bfhi(unsigned w) { return __uint_as_float(w & 0xffff0000u); }
__device__ __forceinline__ unsigned short f2h(float f) { return __builtin_bit_cast(unsigned short, (_Float16)f); }
__device__ __forceinline__ float h2f(unsigned short h) { return (float)__builtin_bit_cast(_Float16, h); }
__device__ __forceinline__ float sigmoidf_(float x) { return __builtin_amdgcn_rcpf(1.0f + __expf(-x)); }
__device__ __forceinline__ float siluf_(float x) { return x * sigmoidf_(x); }
__device__ __forceinline__ void row_info(int r, int& seq, int& pos) {
    if (r < RP) { seq = r / LP; pos = r - seq * LP; } else { const int q = (r - RP) / LS; seq = 32 + q; pos = (r - RP) - q * LS; }
}

__device__ __forceinline__ int pad_row(int o) { return o + 32 * ((o < 65536 ? (o >> 11) : 32 + ((o - 65536) >> 13)) + 1); }

namespace pg8 {
constexpr int BM = 256, BK = 64, HALF = 128, HTB = HALF * BK * 2, STAGE_BYTES = 8 * HTB, NXCD = 8, WGM = 8;
__host__ __device__ __forceinline__ int lds_byte(int r, int c) { const int st = (r >> 4) * 2 + (c >> 5), rr = r & 15, cc = c & 31, ob = rr * 64 + cc * 2; return st * 1024 + (ob ^ (((ob >> 9) & 1) << 5)); }
__host__ __device__ __forceinline__ void stage_rc(int b, int& Rr, int& C) { const int st = b / 1024, sb = b % 1024, swz = sb ^ (((sb >> 9) & 1) << 5); Rr = (st >> 1) * 16 + swz / 64; C = (st & 1) * 32 + (swz % 64) / 2; }
__host__ __device__ __forceinline__ int perm32(int rho) { const int n = rho >> 4, i = rho & 15; return 8 * (i >> 2) + 4 * n + (i & 3); }
struct Unit { int pm, pn; };
struct StaticOrder {
    int nM, nN, nwg, G, c;
    __device__ void init(int M, int N, int G_, int c_) { nM = M / BM; nN = N / BM; nwg = nM * nN; G = G_; c = c_; }
    __device__ bool next(int i, Unit& u) const {
        const long L = (long)i * G + c; if (L >= nwg) return false;
        int wgid = (int)L; { const int q = nwg / NXCD, r = nwg % NXCD, xcd = wgid % NXCD, off = wgid / NXCD; wgid = (xcd < r ? xcd * (q + 1) : r * (q + 1) + (xcd - r) * q) + off; }
        const int nig = WGM * nN, gid = wgid / nig, fm = gid * WGM, gsz = (nM - fm) < WGM ? (nM - fm) : WGM;
        u.pm = fm + ((wgid % nig) % gsz); u.pn = (wgid % nig) / gsz; return true;
    }
};
template <class Epi>
__device__ __forceinline__ void gemm_phase(LAS unsigned char* lds, const bf16_t* A, const bf16_t* Bt, int M, int N, int K, const Epi& E, int stag_ticks = 0) {
    const int tid = threadIdx.x, wid = __builtin_amdgcn_readfirstlane(tid >> 6), lane = tid & 63, wr = wid >> 2, wc = wid & 3, fr = lane & 15, fq = lane >> 4;
    const int nt = K / BK;
    StaticOrder S; S.init(M, N, (int)gridDim.x, (int)blockIdx.x);
    unsigned voffA[2], voffB[2];
#pragma unroll
    for (int i = 0; i < 2; ++i) { int Rr, C; stage_rc(tid * 16 + i * 8192, Rr, C); const int Rb = (Rr & ~31) + perm32(Rr & 31);
        voffA[i] = (unsigned)(Rr * K + C) * 2u; voffB[i] = (unsigned)(Rb * K + C) * 2u; }
    const size_t kstep = (size_t)(BK * 2);
    const size_t hstep = (size_t)HALF * K * 2;
    const size_t tstep = 2 * hstep;
    const unsigned ldsw = (unsigned)wid * 1024u;
    const int aoff = lds_byte(wr * 64 + fr, fq * 8), boff = lds_byte(wc * 32 + fr, fq * 8);
#define PG8_SA(b, h) (((b) * 2 + (h)) * HTB)
#define PG8_SB(b, h) ((4 + (b) * 2 + (h)) * HTB)
#define PG8_STAGE(bufoff, gbase, voff) do { _Pragma("unroll") for (int _i = 0; _i < 2; ++_i) \
        __builtin_amdgcn_global_load_lds((const unsigned*)((const char*)(gbase) + (voff)[_i]), (LAS unsigned*)(lds + (bufoff) + ldsw + _i * 8192), 16, 0, 0); } while (0)
#define PG8_LDA(dst, b, h) do { _Pragma("unroll") for (int m = 0; m < 4; ++m) _Pragma("unroll") for (int k = 0; k < 2; ++k) dst[m][k] = *(const LAS bf16x8*)(lds + PG8_SA(b, h) + aoff + m * 2048 + k * 1024); } while (0)
#define PG8_LDB(dst, b, h) do { _Pragma("unroll") for (int n = 0; n < 2; ++n) _Pragma("unroll") for (int k = 0; k < 2; ++k) dst[n][k] = *(const LAS bf16x8*)(lds + PG8_SB(b, h) + boff + n * 2048 + k * 1024); } while (0)
#define PG8_MMA(ai, bj, At, Bt_) do { __builtin_amdgcn_s_setprio(1); _Pragma("unroll") for (int m = 0; m < 4; ++m) _Pragma("unroll") for (int n = 0; n < 2; ++n) _Pragma("unroll") for (int k = 0; k < 2; ++k) \
        acc[ai][bj][m][n] = __builtin_amdgcn_mfma_f32_16x16x32_bf16(Bt_[n][k], At[m][k], acc[ai][bj][m][n], 0, 0, 0); __builtin_amdgcn_s_setprio(0); } while (0)
#define PG8_WAIT_V(n) asm volatile("s_waitcnt vmcnt(" #n ")" ::: "memory")
#define PG8_WAIT_L(n) asm volatile("s_waitcnt lgkmcnt(" #n ")" ::: "memory")
#define PG8_BAR __builtin_amdgcn_s_barrier()
#define PG8_SCHED __builtin_amdgcn_sched_barrier(0)
    Unit cur, nxt; int ui = 0;
    if (!S.next(0, cur)) return;
    if (stag_ticks) { const unsigned long long t0 = __builtin_amdgcn_s_memrealtime(), tgt = (unsigned long long)(((blockIdx.x >> 3) & 3) * stag_ticks);
        while (__builtin_amdgcn_s_memrealtime() - t0 < tgt) __builtin_amdgcn_s_sleep(4); }
    f32x4 acc[2][2][4][2];
#pragma unroll
    for (int a = 0; a < 2; ++a)
#pragma unroll
        for (int b = 0; b < 2; ++b)
#pragma unroll
            for (int m = 0; m < 4; ++m)
#pragma unroll
                for (int n = 0; n < 2; ++n) acc[a][b][m][n] = (f32x4){0.f, 0.f, 0.f, 0.f};
    bf16x8 At[4][2], B0[2][2], B1[2][2];
    const char* cA = (const char*)A + (size_t)cur.pm * tstep; const char* cB = (const char*)Bt + (size_t)cur.pn * tstep;
    PG8_STAGE(PG8_SB(0, 0), cB, voffB); PG8_STAGE(PG8_SA(0, 0), cA, voffA); PG8_STAGE(PG8_SB(0, 1), cB + hstep, voffB); PG8_STAGE(PG8_SA(0, 1), cA + hstep, voffA);
    if (wr == 1) PG8_BAR;
    PG8_WAIT_V(4); PG8_BAR;
    PG8_STAGE(PG8_SB(1, 0), cB + kstep, voffB); PG8_STAGE(PG8_SA(1, 0), cA + kstep, voffA); PG8_STAGE(PG8_SB(1, 1), cB + hstep + kstep, voffB);
    PG8_WAIT_V(6); PG8_BAR;
    for (;;) {
        const bool has_next = S.next(ui + 1, nxt);
        const char* nA = has_next ? (const char*)A + (size_t)nxt.pm * tstep : cA; const char* nB = has_next ? (const char*)Bt + (size_t)nxt.pn * tstep : cB;
        for (int t = 0; t < nt; t += 2) {
            const bool last = (t == nt - 2);
            const char* a1 = cA + (size_t)(t + 1) * kstep;
            const char* a2 = last ? nA : cA + (size_t)(t + 2) * kstep; const char* b2 = last ? nB : cB + (size_t)(t + 2) * kstep;
            const char* a3 = a2 + kstep; const char* b3 = b2 + kstep;
            PG8_LDB(B0, 0, 0); PG8_SCHED; PG8_LDA(At, 0, 0); PG8_STAGE(PG8_SA(1, 1), a1 + hstep, voffA);
            PG8_WAIT_L(8); PG8_BAR; PG8_WAIT_L(0); PG8_MMA(0, 0, At, B0); PG8_BAR; PG8_SCHED;
            PG8_LDB(B1, 0, 1); PG8_STAGE(PG8_SB(0, 0), b2, voffB);
            PG8_BAR; PG8_WAIT_L(0); PG8_MMA(0, 1, At, B1); PG8_BAR;
            PG8_LDA(At, 0, 1); PG8_STAGE(PG8_SA(0, 0), a2, voffA);
            PG8_BAR; PG8_WAIT_L(0); PG8_MMA(1, 0, At, B0); PG8_BAR; PG8_SCHED;
            PG8_STAGE(PG8_SB(0, 1), b2 + hstep, voffB);
            PG8_WAIT_V(6); PG8_BAR; PG8_MMA(1, 1, At, B1); PG8_BAR;
            PG8_LDB(B0, 1, 0); PG8_SCHED; PG8_LDA(At, 1, 0); PG8_STAGE(PG8_SA(0, 1), a2 + hstep, voffA);
            PG8_WAIT_L(8); PG8_BAR; PG8_WAIT_L(0); PG8_MMA(0, 0, At, B0); PG8_BAR; PG8_SCHED;
            PG8_LDB(B1, 1, 1); PG8_STAGE(PG8_SB(1, 0), b3, voffB);
            PG8_BAR; PG8_WAIT_L(0); PG8_MMA(0, 1, At, B1); PG8_BAR;
            PG8_LDA(At, 1, 1); PG8_STAGE(PG8_SA(1, 0), a3, voffA);
            PG8_BAR; PG8_WAIT_L(0); PG8_MMA(1, 0, At, B0); PG8_BAR; PG8_SCHED;
            PG8_STAGE(PG8_SB(1, 1), b3 + hstep, voffB);
            PG8_WAIT_V(6); PG8_BAR; PG8_MMA(1, 1, At, B1); PG8_BAR;
        }
        E(acc, cur, wr, wc, fr, fq);
        if (!has_next) break;
#pragma unroll
        for (int a = 0; a < 2; ++a)
#pragma unroll
            for (int b = 0; b < 2; ++b)
#pragma unroll
                for (int m = 0; m < 4; ++m)
#pragma unroll
                    for (int n = 0; n < 2; ++n) acc[a][b][m][n] = (f32x4){0.f, 0.f, 0.f, 0.f};
        cur = nxt; cA = nA; cB = nB; ++ui;
    }
    PG8_WAIT_V(0);
    if (wr == 0) PG8_BAR;
    PG8_BAR;
#undef PG8_SA
#undef PG8_SB
#undef PG8_STAGE
#undef PG8_LDA
#undef PG8_LDB
#undef PG8_MMA
#undef PG8_WAIT_V
#undef PG8_WAIT_L
#undef PG8_BAR
#undef PG8_SCHED
}
}
using pg8::Unit;
typedef f32x4 Acc[2][2][4][2];

template <int MODE> struct EpiPair {
    bf16_t* O; int ldo; int pn0; const float* ss; int padmap;
    __device__ __forceinline__ void operator()(const Acc& acc, const Unit& u, int wr, int wc, int fr, int fq) const {
        const int col = (u.pn - pn0) * 128 + wc * 32 + fq * 8;
        const int rbase = u.pm * 256 + wr * 64 + fr;
        float sv[8];
#pragma unroll
        for (int q = 0; q < 8; ++q) sv[q] = ss[rbase + (q >> 2) * 128 + (q & 3) * 16];
#pragma unroll
        for (int ai = 0; ai < 2; ++ai)
#pragma unroll
            for (int m = 0; m < 4; ++m) {
                const int r = rbase + ai * 128 + m * 16;
                const float s = __builtin_amdgcn_rsqf(sv[ai * 4 + m] * (1.0f / 1024.0f) + RMS_EPS);
                float o[8];
#pragma unroll
                for (int n = 0; n < 2; ++n)
#pragma unroll
                    for (int j = 0; j < 4; ++j) { const float a = acc[ai][0][m][n][j] * s, b = acc[ai][1][m][n][j] * s; o[n * 4 + j] = MODE == 0 ? siluf_(a) * b : a * sigmoidf_(b); }
                u32x4 w; w.x = cvt_pk_bf16(o[0], o[1]); w.y = cvt_pk_bf16(o[2], o[3]); w.z = cvt_pk_bf16(o[4], o[5]); w.w = cvt_pk_bf16(o[6], o[7]);
                *(u32x4*)(O + (size_t)(padmap ? pad_row(r) : r) * ldo + col) = w;
            }
    }
};
template <int MODE> struct EpiRes {
    const bf16_t* src; bf16_t* dst; float* ss;
    __device__ __forceinline__ void operator()(const Acc& acc, const Unit& u, int wr, int wc, int fr, int fq) const {
        const int col0 = u.pn * 256 + wc * 32 + fq * 8;
        const float sc = (MODE == 1) ? 1.0f : 0.5f;
        u32x4 hwa[2][4][2];
#pragma unroll
        for (int ai = 0; ai < 2; ++ai)
#pragma unroll
            for (int m = 0; m < 4; ++m) { int r = u.pm * 256 + ai * 128 + wr * 64 + m * 16 + fr;
                const bf16_t* hp = src + (size_t)r * 1024 + col0; hwa[ai][m][0] = *(const u32x4*)hp; hwa[ai][m][1] = *(const u32x4*)(hp + 128); }
#pragma unroll
        for (int ai = 0; ai < 2; ++ai) {
#pragma unroll
            for (int m = 0; m < 4; ++m) {
                const int r = u.pm * 256 + ai * 128 + wr * 64 + m * 16 + fr;
                bf16_t* hp = dst + (size_t)r * 1024 + col0;
                float sq = 0.f;
#pragma unroll
                for (int bj = 0; bj < 2; ++bj) {
                    const u32x4 h = hwa[ai][m][bj];
                    const f32x4 a0 = acc[ai][bj][m][0] * sc, a1 = acc[ai][bj][m][1] * sc;
                    const float v[8] = {bflo(h.x) + a0[0], bfhi(h.x) + a0[1], bflo(h.y) + a0[2], bfhi(h.y) + a0[3], bflo(h.z) + a1[0], bfhi(h.z) + a1[1], bflo(h.w) + a1[2], bfhi(h.w) + a1[3]};
                    u32x4 w; w.x = cvt_pk_bf16(v[0], v[1]); w.y = cvt_pk_bf16(v[2], v[3]); w.z = cvt_pk_bf16(v[4], v[5]); w.w = cvt_pk_bf16(v[6], v[7]);
                    *(u32x4*)(hp + bj * 128) = w;
                    sq += (v[0] * v[0] + v[1] * v[1]) + (v[2] * v[2] + v[3] * v[3]) + (v[4] * v[4] + v[5] * v[5]) + (v[6] * v[6] + v[7] * v[7]);
                }
                sq += __shfl_xor(sq, 16); sq += __shfl_xor(sq, 32);
                if (fq == 0) atomicAdd(ss + r, sq);
            }
        }
    }
};
struct EpiZa {
    bf16_t* q; bf16_t* v; unsigned short* lfo; const float* ss; const float* lbv;
    template <int KIND> __device__ __forceinline__ void run(const Acc& acc, const Unit& u, int wr, int wc, int fr, int fq) const {
        const int cw = wc * 32 + fq * 8;
        const int rbase = u.pm * 256 + wr * 64 + fr;
        float sv[8];
#pragma unroll
        for (int qq = 0; qq < 8; ++qq) sv[qq] = ss[rbase + (qq >> 2) * 128 + (qq & 3) * 16];
        f32x4 lbr[2][2];
        if (KIND == 1) {
            const int c = (u.pn - 2) * 256 + cw;
#pragma unroll
            for (int bj = 0; bj < 2; ++bj) { lbr[bj][0] = *(const f32x4*)(lbv + c + bj * 128); lbr[bj][1] = *(const f32x4*)(lbv + c + bj * 128 + 4); }
        }
#pragma unroll
        for (int ai = 0; ai < 2; ++ai)
#pragma unroll
            for (int m = 0; m < 4; ++m) {
                const int r = rbase + ai * 128 + m * 16;
                const float s = __builtin_amdgcn_rsqf(sv[ai * 4 + m] * (1.0f / 1024.0f) + RMS_EPS);
                const size_t rp = (size_t)pad_row(r);
#pragma unroll
                for (int bj = 0; bj < 2; ++bj) {
                    float z[8];
#pragma unroll
                    for (int n = 0; n < 2; ++n)
#pragma unroll
                        for (int j = 0; j < 4; ++j) z[n * 4 + j] = acc[ai][bj][m][n][j] * s;
                    u32x4 w;
                    if (KIND == 0) {
#pragma unroll
                        for (int e = 0; e < 8; ++e) z[e] = siluf_(z[e]);
                        w.x = cvt_pk_bf16(z[0], z[1]); w.y = cvt_pk_bf16(z[2], z[3]); w.z = cvt_pk_bf16(z[4], z[5]); w.w = cvt_pk_bf16(z[6], z[7]);
                        *(u32x4*)(q + rp * 512 + u.pn * 256 + bj * 128 + cw) = w;
                    } else if (KIND == 1) {
                        const int c = (u.pn - 2) * 256 + bj * 128 + cw;
                        unsigned short hh[8];
#pragma unroll
                        for (int e = 0; e < 8; ++e) { const float lb = lbr[bj][e >> 2][e & 3]; const float f = lb + (1.0f - lb) * sigmoidf_(z[e]); hh[e] = f2h(f); }
                        w.x = hh[0] | ((unsigned)hh[1] << 16); w.y = hh[2] | ((unsigned)hh[3] << 16); w.z = hh[4] | ((unsigned)hh[5] << 16); w.w = hh[6] | ((unsigned)hh[7] << 16);
                        *(u32x4*)(lfo + rp * 1024 + c) = w;
                    } else {
                        w.x = cvt_pk_bf16(z[0], z[1]); w.y = cvt_pk_bf16(z[2], z[3]); w.z = cvt_pk_bf16(z[4], z[5]); w.w = cvt_pk_bf16(z[6], z[7]);
                        *(u32x4*)(v + rp * 512 + (u.pn - 6) * 256 + bj * 128 + cw) = w;
                    }
                }
            }
    }
    __device__ __forceinline__ void operator()(const Acc& acc, const Unit& u, int wr, int wc, int fr, int fq) const {
        if (u.pn < 2) run<0>(acc, u, wr, wc, fr, fq); else if (u.pn < 6) run<1>(acc, u, wr, wc, fr, fq); else run<2>(acc, u, wr, wc, fr, fq);
    }
};
struct EpiZb {
    bf16_t* gate; bf16_t* glu; const float* ss;
    __device__ __forceinline__ void operator()(const Acc& acc, const Unit& u, int wr, int wc, int fr, int fq) const {
        if (u.pn >= 2) { EpiPair<1> e{glu, 512, 2, ss, 1}; e(acc, u, wr, wc, fr, fq); return; }
        const int cw = wc * 32 + fq * 8;
        const int rbase = u.pm * 256 + wr * 64 + fr;
        float sv[8];
#pragma unroll
        for (int qq = 0; qq < 8; ++qq) sv[qq] = ss[rbase + (qq >> 2) * 128 + (qq & 3) * 16];
#pragma unroll
        for (int ai = 0; ai < 2; ++ai)
#pragma unroll
            for (int m = 0; m < 4; ++m) {
                const int r = rbase + ai * 128 + m * 16;
                const float s = __builtin_amdgcn_rsqf(sv[ai * 4 + m] * (1.0f / 1024.0f) + RMS_EPS);
#pragma unroll
                for (int bj = 0; bj < 2; ++bj) {
                    float z[8];
#pragma unroll
                    for (int n = 0; n < 2; ++n)
#pragma unroll
                        for (int j = 0; j < 4; ++j) z[n * 4 + j] = siluf_(acc[ai][bj][m][n][j] * s);
                    u32x4 w; w.x = cvt_pk_bf16(z[0], z[1]); w.y = cvt_pk_bf16(z[2], z[3]); w.z = cvt_pk_bf16(z[4], z[5]); w.w = cvt_pk_bf16(z[6], z[7]);
                    *(u32x4*)(gate + (size_t)pad_row(r) * 512 + u.pn * 256 + bj * 128 + cw) = w;
                }
            }
    }
};

struct EpiZ {
    EpiZa a; EpiZb b;
    __device__ __forceinline__ void operator()(const Acc& acc, const Unit& u, int wr, int wc, int fr, int fq) const {
        if (u.pn < 8) a(acc, u, wr, wc, fr, fq); else { const Unit u2{u.pm, u.pn - 8}; b(acc, u2, wr, wc, fr, fq); }
    }
};

template <int STAGE, int NC> __device__ __forceinline__ void meta_stage(LAS unsigned char* lds, const Params& p, int blk) {
    unsigned char* ws = p.ws;
    float* hidm = (float*)(ws + OFF_META);
    float* h1m = (float*)(ws + OFF_META + 196608);
    constexpr int NKS = 512 / NC;
    constexpr int NPL = 2560 / NC;
    const int t = threadIdx.x, col = t % NC, ks = t / NC, lane = t & 63, wave = t >> 6;
    LAS float* red = (LAS float*)lds;
    LAS float* rsl = (LAS float*)(lds + 65536);
    constexpr int K = STAGE == 2 ? 2816 : 1024;
    const float* A = STAGE == 1 ? p.in[2] : (STAGE == 2 ? hidm : h1m);
    const float* gain = STAGE == 1 ? p.in[3] : (STAGE == 3 ? p.in[7] : nullptr);
    const bool pair = (STAGE == 1) || (STAGE == 3 && blk >= NPL);
    const float* W0; const float* W1 = nullptr; int ldw;
    if (STAGE == 1) { W0 = p.in[4] + blk * NC; W1 = p.in[5] + blk * NC; ldw = FF; }
    else if (STAGE == 2) { W0 = p.in[6] + blk * NC; ldw = 1024; }
    else { ldw = 3584; if (blk < NPL) W0 = p.in[8] + blk * NC; else { W0 = p.in[8] + 2560 + (blk - NPL) * NC; W1 = p.in[8] + 3072 + (blk - NPL) * NC; } }
    if (STAGE != 2) {
#pragma unroll
        for (int q = 0; q < 2; ++q) { const int m = wave * 2 + q; float sq = 0.f;
            for (int k = lane; k < 1024; k += 64) { const float a = A[m * 1024 + k]; sq += a * a; }
#pragma unroll
            for (int o = 32; o >= 1; o >>= 1) sq += __shfl_xor(sq, o);
            if (lane == 0) rsl[m] = __builtin_amdgcn_rsqf(sq * (1.0f / 1024.0f) + RMS_EPS); }
    }
    float a0[16], a1[16];
#pragma unroll
    for (int m = 0; m < 16; ++m) { a0[m] = 0.f; a1[m] = 0.f; }
    const int kb = ks * (K / NKS);
    for (int k = kb; k < kb + K / NKS; k += 4) {
        f32x4 av[16];
#pragma unroll
        for (int m = 0; m < 16; ++m) av[m] = *(const f32x4*)(A + (size_t)m * K + k);
#pragma unroll
        for (int e = 0; e < 4; ++e) {
            const float g = gain ? gain[k + e] : 1.0f;
            const float w0 = W0[(size_t)(k + e) * ldw + col] * g;
            const float w1 = pair ? W1[(size_t)(k + e) * ldw + col] * g : 0.f;
#pragma unroll
            for (int m = 0; m < 16; ++m) { a0[m] += av[m][e] * w0; a1[m] += av[m][e] * w1; }
        }
    }
#pragma unroll
    for (int m = 0; m < 16; ++m) { red[(ks * NC + col) * 32 + m] = a0[m]; red[(ks * NC + col) * 32 + 16 + m] = a1[m]; }
    __syncthreads();
    if (t < 16 * NC) { const int m = t / NC;
      float s0 = 0.f, s1 = 0.f;
#pragma unroll 8
      for (int q = 0; q < NKS; ++q) { s0 += red[(q * NC + col) * 32 + m]; s1 += red[(q * NC + col) * 32 + 16 + m]; }
      if (STAGE == 1) { const float rs = rsl[m]; hidm[m * 2816 + blk * NC + col] = siluf_(s0 * rs) * (s1 * rs); }
      else if (STAGE == 2) { const int n = blk * NC + col; h1m[m * 1024 + n] = p.in[2][m * 1024 + n] + 0.5f * s0; }
      else {
          const float rs = rsl[m]; const float z0 = s0 * rs, z1 = s1 * rs;
          bf16_t* qb = (bf16_t*)(ws + OFF_Y + Y_Q); bf16_t* vb = (bf16_t*)(ws + OFF_Y + Y_V); unsigned short* lfo = (unsigned short*)(ws + OFF_Y + Y_LFO);
          bf16_t* gateb = (bf16_t*)p.out + (size_t)R * 1024; bf16_t* glub = (bf16_t*)(ws + OFF_Y + Y_GLU);
          unsigned short* dstp; size_t ld; int c; unsigned short val, padval = 0;
          if (blk >= NPL) { c = (blk - NPL) * NC + col; dstp = glub; ld = 512; val = (unsigned short)(cvt_pk_bf16(z0 * sigmoidf_(z1), 0.f) & 0xffff); }
          else { const int cz = blk * NC + col;
              if (cz < 512) { c = cz; dstp = qb; ld = 512; val = (unsigned short)(cvt_pk_bf16(siluf_(z0), 0.f) & 0xffff); }
              else if (cz < 1536) { c = cz - 512; dstp = lfo; ld = 1024; const float lb = ((const float*)(ws + OFF_LB))[c]; val = f2h(lb + (1.0f - lb) * sigmoidf_(z0)); padval = f2h(1.0f); }
              else if (cz < 2048) { c = cz - 1536; dstp = vb; ld = 512; val = (unsigned short)(cvt_pk_bf16(z0, 0.f) & 0xffff); }
              else { c = cz - 2048; dstp = gateb; ld = 512; val = (unsigned short)(cvt_pk_bf16(siluf_(z0), 0.f) & 0xffff); } }
          for (int sq_ = 0; sq_ < 40; ++sq_) { const size_t base = sq_ < 32 ? (size_t)sq_ * LP : (size_t)RP + (size_t)(sq_ - 32) * LS;
              dstp[(base + 16 + m) * ld + c] = val;
              dstp[(base + m) * ld + c] = padval; }
      }
    }
    __syncthreads();
}

__device__ __forceinline__ void cvt_tile(LAS float* tile, const float* s0, const float* s1, int ld, int mode, const float* gain, bf16_t* dst, int K, int kt, int ntile) {
    const int t = threadIdx.x;
    const int n0 = ntile * 64, k0 = kt * 64;
    const float* src; int col0;
    if (mode == 0) { src = s0; col0 = n0; } else { const int pn = n0 >> 8, w = n0 & 255; src = w < 128 ? s0 : s1; col0 = pn * 128 + (w & 127); }
#pragma unroll
    for (int p = 0; p < 2; ++p) {
        const int kk = (t >> 4) + p * 32, c4 = (t & 15) * 4;
        f32x4 v = *(const f32x4*)(src + (size_t)(k0 + kk) * ld + col0 + c4);
        const float g = gain ? gain[k0 + kk] : 1.0f;
#pragma unroll
        for (int e = 0; e < 4; ++e) tile[kk * 65 + c4 + e] = v[e] * g;
    }
    __syncthreads();
    { const int n = t >> 3, k8 = (t & 7) * 8; float x[8];
#pragma unroll
      for (int j = 0; j < 8; ++j) x[j] = tile[(k8 + j) * 65 + n];
      u32x4 w; w.x = cvt_pk_bf16(x[0], x[1]); w.y = cvt_pk_bf16(x[2], x[3]); w.z = cvt_pk_bf16(x[4], x[5]); w.w = cvt_pk_bf16(x[6], x[7]);
      *(u32x4*)(dst + (size_t)(n0 + n) * K + k0 + k8) = w; }
    __syncthreads();
}
__device__ __forceinline__ void phase_prep(LAS unsigned char* lds, const Params& p) {
    unsigned char* ws = p.ws;
    LAS float* tile = (LAS float*)lds;
    const int J1 = 16 * 88, J2 = 44 * 16, J3A = 16 * 32, J3B = 16 * 24, J4 = 16 * 16;
    const int total = J1 + J2 + J3A + J3B + J4 + J1 + J2;
    for (int job = blockIdx.x; job < total; job += gridDim.x) {
        int j = job;
        const float* s0; const float* s1 = nullptr; const float* gain = nullptr; int ld, mode = 0, K, kt, nt_; bf16_t* dst;
        if (j < J1) { s0 = p.in[4]; s1 = p.in[5]; ld = FF; mode = 1; gain = p.in[3]; dst = (bf16_t*)(ws + OFF_W1); K = 1024; kt = j % 16; nt_ = j / 16; }
        else if ((j -= J1) < J2) { s0 = p.in[6]; ld = 1024; dst = (bf16_t*)(ws + OFF_W2); K = FF; kt = j % 44; nt_ = j / 44; }
        else if ((j -= J2) < J3A) { s0 = p.in[8]; ld = 3584; gain = p.in[7]; dst = (bf16_t*)(ws + OFF_W3A); K = 1024; kt = j % 16; nt_ = j / 16; }
        else if ((j -= J3A) < J3B) { ld = 3584; gain = p.in[7]; K = 1024; kt = j % 16; nt_ = j / 16;
            if (nt_ < 8) { s0 = p.in[8] + 2048; dst = (bf16_t*)(ws + OFF_W3B); }
            else { s0 = p.in[8] + 2560; s1 = p.in[8] + 3072; mode = 1; dst = (bf16_t*)(ws + OFF_W3B) + (size_t)512 * 1024; nt_ -= 8; } }
        else if ((j -= J3B) < J4) { s0 = p.in[15]; ld = 1024; dst = (bf16_t*)(ws + OFF_W4); K = 1024; kt = j % 16; nt_ = j / 16; }
        else if ((j -= J4) < J1) { s0 = p.in[17]; s1 = p.in[18]; ld = FF; mode = 1; gain = p.in[16]; dst = (bf16_t*)(ws + OFF_W5); K = 1024; kt = j % 16; nt_ = j / 16; }
        else { j -= J1; s0 = p.in[19]; ld = 1024; dst = (bf16_t*)(ws + OFF_W6); K = FF; kt = j % 44; nt_ = j / 44; }
        cvt_tile(tile, s0, s1, ld, mode, gain, dst, K, kt, nt_);
    }
    if (blockIdx.x == 0) for (int i = threadIdx.x; i < 1024; i += NTHREADS) { const float l0 = p.in[9][i], l1 = p.in[9][1024 + i]; ((float*)(ws + OFF_LB))[i] = 1.0f / (1.0f + __expf(l1 - l0)); }
    float* ss = (float*)(ws + OFF_SS);
    bf16_t* hb = (bf16_t*)(ws + OFF_X);
    const int wave = threadIdx.x >> 6, lane = threadIdx.x & 63;
    for (int r0 = (blockIdx.x * 8 + wave) * 4; r0 < NRC; r0 += gridDim.x * 32) {
        f32x4 v[4][4];
#pragma unroll
        for (int q = 0; q < 4; ++q) {
            const long orow = r0 + q;
            const float* src = orow < 65536 ? p.in[0] + orow * 1024 : p.in[1] + (orow - 65536) * 1024;
#pragma unroll
            for (int j = 0; j < 4; ++j) v[q][j] = *(const f32x4*)(src + j * 256 + lane * 4);
        }
#pragma unroll
        for (int q = 0; q < 4; ++q) {
            const int r = r0 + q; float sq = 0.f;
#pragma unroll
            for (int j = 0; j < 4; ++j) {
                const f32x4 x = v[q][j];
                sq += (x[0] * x[0] + x[1] * x[1]) + (x[2] * x[2] + x[3] * x[3]);
                u32x2 w; w.x = cvt_pk_bf16(x[0], x[1]); w.y = cvt_pk_bf16(x[2], x[3]);
                *(u32x2*)(hb + (size_t)r * 1024 + j * 256 + lane * 4) = w;
            }
#pragma unroll
            for (int o = 32; o >= 1; o >>= 1) sq += __shfl_xor(sq, o);
            if (lane == 0) { ss[r] = sq; ss[R + r] = 0.f; ss[2 * R + r] = 0.f; ss[3 * R + r] = 0.f; }
        }
    }
    if (blockIdx.x < 176) meta_stage<1, 16>(lds, p, blockIdx.x);
}

constexpr int SC_QT = 0, SC_KT = 8704, SC_KTT = 17408, SC_VT = 27648, SC_E1 = 32768, SC_E2 = 33280, SC_BUF = 33792;
struct ScanJob { int nch, rb, dir; size_t fcol, qcol, vcol; };
__device__ __forceinline__ size_t scan_row(const ScanJob& J, int c, int i) { return (size_t)J.rb + c * 32 + (J.dir ? 31 - i : i); }
constexpr int SC_RAW = 2 * SC_BUF, SC_RAW_SZ = 20480, SC_RF = 0, SC_RQ = 8192, SC_RV = 16384;
__device__ __forceinline__ void scan_vload(const ScanJob& J, int cidx, const unsigned short* lfo, const bf16_t* qb, const bf16_t* vb, int tp, u32x4 (&rg)[5]) {
    if (cidx >= J.nch) return;
    const int c = J.dir ? J.nch - 1 - cidx : cidx;
#pragma unroll
    for (int h = 0; h < 2; ++h) { const int pc = tp + h * 256; const size_t r = scan_row(J, c, pc >> 4); const int part = (pc & 15) * 8;
        rg[h] = *(const u32x4*)(lfo + r * 1024 + J.fcol + part); rg[2 + h] = *(const u32x4*)(qb + r * 512 + J.qcol + part); }
    { const size_t r = scan_row(J, c, tp >> 3); rg[4] = *(const u32x4*)(vb + r * 512 + J.vcol + (tp & 7) * 8); }
}
__device__ __forceinline__ void scan_vstore(LAS unsigned char* raw, int tp, const u32x4 (&rg)[5]) {
#pragma unroll
    for (int h = 0; h < 2; ++h) { const int pc = tp + h * 256; *(LAS u32x4*)(raw + SC_RF + pc * 16) = rg[h]; *(LAS u32x4*)(raw + SC_RQ + pc * 16) = rg[2 + h]; }
    *(LAS u32x4*)(raw + SC_RV + tp * 16) = rg[4];
}
__device__ __forceinline__ void scan_prep(LAS unsigned char* lds, const ScanJob& J, int cidx, int tp) {
    const LAS unsigned char* raw = lds + SC_RAW + (cidx & 1) * SC_RAW_SZ;
    unsigned short fr_[16], qr_[16], vr_[8];
    { const int ch_ = tp & 127, seg_ = tp >> 7, vch_ = tp & 63, vseg_ = tp >> 6;
#pragma unroll
      for (int j = 0; j < 16; ++j) { fr_[j] = *(const LAS unsigned short*)(raw + SC_RF + (seg_ * 16 + j) * 256 + ch_ * 2); qr_[j] = *(const LAS unsigned short*)(raw + SC_RQ + (seg_ * 16 + j) * 256 + ch_ * 2); }
#pragma unroll
      for (int j = 0; j < 8; ++j) vr_[j] = *(const LAS unsigned short*)(raw + SC_RV + (vseg_ * 8 + j) * 128 + vch_ * 2); }
    LAS unsigned char* B = lds + (cidx & 1) * SC_BUF;
    const int ch = tp & 127, seg = tp >> 7, vch = tp & 63, vseg = tp >> 6;
    float tot = 1.0f;
#pragma unroll
    for (int j = 0; j < 16; ++j) tot *= h2f(fr_[j]);
    const float sc = seg == 0 ? 1.0f / tot : 1.0f;
    unsigned short kt16[16];
    float run = sc;
#pragma unroll
    for (int j = 0; j < 16; ++j) {
        const float f = h2f(fr_[j]);
        run *= f;
        const float E = run, Ri = __builtin_amdgcn_rcpf(E);
        const unsigned pk = cvt_pk_bf16(bf2f(qr_[j]) * E, (1.0f - f) * Ri);
        const int i = seg * 16 + j;
        *(LAS unsigned short*)(B + SC_QT + i * 272 + ch * 2) = (unsigned short)(pk & 0xffff);
        *(LAS unsigned short*)(B + SC_KT + i * 272 + ch * 2) = (unsigned short)(pk >> 16);
        kt16[j] = (unsigned short)(pk >> 16);
    }
    { u32x4 w0, w1;
      w0.x = kt16[0] | ((unsigned)kt16[1] << 16); w0.y = kt16[2] | ((unsigned)kt16[3] << 16); w0.z = kt16[4] | ((unsigned)kt16[5] << 16); w0.w = kt16[6] | ((unsigned)kt16[7] << 16);
      w1.x = kt16[8] | ((unsigned)kt16[9] << 16); w1.y = kt16[10] | ((unsigned)kt16[11] << 16); w1.z = kt16[12] | ((unsigned)kt16[13] << 16); w1.w = kt16[14] | ((unsigned)kt16[15] << 16);
      *(LAS u32x4*)(B + SC_KTT + ch * 80 + seg * 32) = w0; *(LAS u32x4*)(B + SC_KTT + ch * 80 + seg * 32 + 16) = w1;
      u32x4 wv; wv.x = vr_[0] | ((unsigned)vr_[1] << 16); wv.y = vr_[2] | ((unsigned)vr_[3] << 16); wv.z = vr_[4] | ((unsigned)vr_[5] << 16); wv.w = vr_[6] | ((unsigned)vr_[7] << 16);
      *(LAS u32x4*)(B + SC_VT + vch * 80 + vseg * 16) = wv; }
    if (seg == 0) { const float e2p = cidx > 0 ? ((const LAS float*)(lds + ((cidx & 1) ^ 1) * SC_BUF + SC_E2))[ch] : 1.0f; ((LAS float*)(B + SC_E1))[ch] = tot * e2p; }
    else ((LAS float*)(B + SC_E2))[ch] = tot;
}
__device__ __forceinline__ void scan_mfma(LAS unsigned char* lds, const ScanJob& J, int cidx, unsigned short* ob, int w, int g, int l15, f32x4 (&S)[8]) {
    LAS unsigned char* B = lds + (cidx & 1) * SC_BUF;
    const int c = J.dir ? J.nch - 1 - cidx : cidx;
#pragma unroll
    for (int kt = 0; kt < 8; ++kt) S[kt] *= *(const LAS f32x4*)(B + SC_E1 + (kt * 16 + g * 4) * 4);
    f32x4 o0 = {0.f, 0.f, 0.f, 0.f}, o1 = o0, c00 = o0, c01 = o0, c11 = o0;
#pragma unroll
    for (int ks = 0; ks < 4; ++ks) {
        bf16x8 Aq[2], Ak[2];
#pragma unroll
        for (int it = 0; it < 2; ++it) {
            const LAS unsigned char* qa = B + SC_QT + (it * 16 + l15) * 272 + (ks * 32 + g * 4) * 2;
            const LAS unsigned char* ka = B + SC_KT + (it * 16 + l15) * 272 + (ks * 32 + g * 4) * 2;
            const u32x2 q0 = *(const LAS u32x2*)qa, q1 = *(const LAS u32x2*)(qa + 32), k0 = *(const LAS u32x2*)ka, k1 = *(const LAS u32x2*)(ka + 32);
            u32x4 qq = {q0.x, q0.y, q1.x, q1.y}, kk = {k0.x, k0.y, k1.x, k1.y};
            Aq[it] = __builtin_bit_cast(bf16x8, qq); Ak[it] = __builtin_bit_cast(bf16x8, kk);
        }
        u32x4 sw; sw.x = cvt_pk_bf16(S[2 * ks][0], S[2 * ks][1]); sw.y = cvt_pk_bf16(S[2 * ks][2], S[2 * ks][3]); sw.z = cvt_pk_bf16(S[2 * ks + 1][0], S[2 * ks + 1][1]); sw.w = cvt_pk_bf16(S[2 * ks + 1][2], S[2 * ks + 1][3]);
        const bf16x8 Sf = __builtin_bit_cast(bf16x8, sw);
        o0 = __builtin_amdgcn_mfma_f32_16x16x32_bf16(Aq[0], Sf, o0, 0, 0, 0);
        o1 = __builtin_amdgcn_mfma_f32_16x16x32_bf16(Aq[1], Sf, o1, 0, 0, 0);
        c00 = __builtin_amdgcn_mfma_f32_16x16x32_bf16(Ak[0], Aq[0], c00, 0, 0, 0);
        c01 = __builtin_amdgcn_mfma_f32_16x16x32_bf16(Ak[0], Aq[1], c01, 0, 0, 0);
        c11 = __builtin_amdgcn_mfma_f32_16x16x32_bf16(Ak[1], Aq[1], c11, 0, 0, 0);
    }
#pragma unroll
    for (int e = 0; e < 4; ++e) { const bool keep = (g * 4 + e) <= l15; c00[e] = keep ? c00[e] : 0.f; c11[e] = keep ? c11[e] : 0.f; }
    { u32x4 pw; pw.x = cvt_pk_bf16(c00[0], c00[1]); pw.y = cvt_pk_bf16(c00[2], c00[3]); pw.z = 0u; pw.w = 0u;
      u32x4 pw1; pw1.x = cvt_pk_bf16(c01[0], c01[1]); pw1.y = cvt_pk_bf16(c01[2], c01[3]); pw1.z = cvt_pk_bf16(c11[0], c11[1]); pw1.w = cvt_pk_bf16(c11[2], c11[3]);
      const LAS unsigned char* va = B + SC_VT + (w * 16 + l15) * 80;
      const u32x2 v0 = *(const LAS u32x2*)(va + g * 8), v1 = *(const LAS u32x2*)(va + 32 + g * 8);
      u32x4 vp = {v0.x, v0.y, v1.x, v1.y};
      const bf16x8 Vp = __builtin_bit_cast(bf16x8, vp);
      o0 = __builtin_amdgcn_mfma_f32_16x16x32_bf16(__builtin_bit_cast(bf16x8, pw), Vp, o0, 0, 0, 0);
      o1 = __builtin_amdgcn_mfma_f32_16x16x32_bf16(__builtin_bit_cast(bf16x8, pw1), Vp, o1, 0, 0, 0);
      const bf16x8 Vn = *(const LAS bf16x8*)(va + g * 16);
#pragma unroll
      for (int kt = 0; kt < 8; ++kt) {
          const bf16x8 Ka = *(const LAS bf16x8*)(B + SC_KTT + (kt * 16 + l15) * 80 + g * 16);
          S[kt] = __builtin_amdgcn_mfma_f32_16x16x32_bf16(Ka, Vn, S[kt], 0, 0, 0);
      }
    }
#pragma unroll
    for (int e = 0; e < 4; ++e) {
        const size_t r0 = scan_row(J, c, g * 4 + e), r1 = scan_row(J, c, 16 + g * 4 + e);
        ob[r0 * 1024 + J.fcol + (J.vcol - J.qcol) + w * 16 + l15] = (unsigned short)(cvt_pk_bf16(o0[e], 0.f) & 0xffff);
        ob[r1 * 1024 + J.fcol + (J.vcol - J.qcol) + w * 16 + l15] = (unsigned short)(cvt_pk_bf16(o1[e], 0.f) & 0xffff);
    }
}
__device__ __forceinline__ void scan_job(LAS unsigned char* lds, const Params& p, int hj) {
    unsigned char* ws = p.ws;
    const bf16_t* qb = (const bf16_t*)(ws + OFF_Y + Y_Q);
    const bf16_t* vb = (const bf16_t*)(ws + OFF_Y + Y_V);
    const unsigned short* lfo = (const unsigned short*)(ws + OFF_Y + Y_LFO);
    unsigned short* ob = (unsigned short*)p.out;
    int seq;
    if (hj < 128) seq = 32 + (hj >> 4); else { hj -= 128; seq = hj >> 4; }
    const int head = (hj >> 2) & 3, dir = (hj >> 1) & 1, dvh = hj & 1;
    ScanJob J;
    J.nch = seq < 32 ? LP / 32 : LS / 32; J.rb = seq < 32 ? seq * LP : RP + (seq - 32) * LS; J.dir = dir;
    J.fcol = (size_t)dir * 512 + head * 128; J.qcol = (size_t)head * 128; J.vcol = J.qcol + dvh * 64;
    const int t = threadIdx.x, lane = t & 63, w = __builtin_amdgcn_readfirstlane(t >> 6), g = lane >> 4, l15 = lane & 15;
    const bool prep = w >= 4;
    const int tp = t & 255;
    if (prep) {
        u32x4 rg[5];
#pragma unroll
        for (int q = 0; q < 5; ++q) rg[q] = (u32x4){0u, 0u, 0u, 0u};
        scan_vload(J, 0, lfo, qb, vb, tp, rg); scan_vstore(lds + SC_RAW, tp, rg); scan_vload(J, 1, lfo, qb, vb, tp, rg);
        __syncthreads();
        for (int k = 0; k <= J.nch; ++k) {
            if (k < J.nch) {
                scan_vstore(lds + SC_RAW + ((k + 1) & 1) * SC_RAW_SZ, tp, rg);
                scan_vload(J, k + 2, lfo, qb, vb, tp, rg);
                scan_prep(lds, J, k, tp);
            }
            __syncthreads();
        }
    } else {
        f32x4 S[8];
#pragma unroll
        for (int k = 0; k < 8; ++k) S[k] = (f32x4){0.f, 0.f, 0.f, 0.f};
        __builtin_amdgcn_s_setprio(2);
        __syncthreads();
        __syncthreads();
        for (int cc = 0; cc < J.nch; ++cc) {
            scan_mfma(lds, J, cc, ob, w, g, l15, S);
            __syncthreads();
        }
        __builtin_amdgcn_s_setprio(0);
    }
}
__device__ __forceinline__ void phase_scan(LAS unsigned char* lds, const Params& p) {
    const int b = blockIdx.x;
    const bool stdg = gridDim.x == 256;
    const int x = b & 7, i16 = (b >> 3) & 15;
    const int slot = ((i16 >> 1) * 8 + x) * 2 + (i16 & 1);
    for (int it = 0;; ++it) {
        int job;
        if (stdg) { if (b < 128) { if (it) break; job = slot; } else { if (it >= 4) break; job = 128 + slot + 128 * it; } }
        else { job = b + it * (int)gridDim.x; if (job >= 640) break; }
        scan_job(lds, p, job);
    }
}

__device__ __forceinline__ void phase_mix(LAS unsigned char* lds, const Params& p) {
    unsigned char* ws = p.ws;
    const bf16_t* gate = (const bf16_t*)p.out + (size_t)R * 1024;
    const bf16_t* glu = (const bf16_t*)(ws + OFF_Y + Y_GLU);
    bf16_t* mix = (bf16_t*)(ws + OFF_Y + Y_LFO);
    const bf16_t* osc = (const bf16_t*)p.out;
    const int t = threadIdx.x, lane = t & 63, w = t >> 6;
    float cw[31];
#pragma unroll
    for (int j = 0; j < 31; ++j) cw[j] = p.in[11][j * 512 + t];
    const float cb = p.in[12][t];
    LAS float* tile = (LAS float*)lds;
    float lg[8], lb_[8], hn[8];
#pragma unroll
    for (int e = 0; e < 8; ++e) { lg[e] = p.in[13][lane * 8 + e]; lb_[e] = p.in[14][lane * 8 + e]; hn[e] = p.in[10][lane * 8 + e]; }
    for (int tix = blockIdx.x; tix < 2048; tix += gridDim.x) {
        int r0; size_t o0;
        if (tix < 1024) { const int sq_ = tix >> 5, k = tix & 31; r0 = sq_ * LP + 32 + 64 * k; o0 = (size_t)sq_ * 2048 + 64 * k; }
        else { const int tt = tix - 1024, q_ = tt >> 7, k = tt & 127; r0 = RP + q_ * LS + 32 + 64 * k; o0 = (size_t)65536 + (size_t)q_ * 8192 + 64 * k; }
        unsigned short xr[94];
#pragma unroll
        for (int i = 0; i < 94; ++i) { int r = r0 - 15 + i; r = r >= R ? R - 1 : r; xr[i] = glu[(size_t)r * 512 + t]; }
        float x[94];
#pragma unroll
        for (int i = 0; i < 94; ++i) { const int r = r0 - 15 + i; x[i] = r < R ? bf2f(xr[i]) : 0.f; }
#pragma unroll
        for (int i = 0; i < 64; ++i) { float a = cb;
#pragma unroll
            for (int j = 0; j < 31; ++j) a += cw[j] * x[i + j];
            tile[i * 512 + t] = a; }
        u32x4 ca[8], cbv[8], cg[8];
#pragma unroll
        for (int rr = 0; rr < 8; ++rr) { const size_t r = (size_t)r0 + w * 8 + rr;
            ca[rr] = *(const u32x4*)(osc + r * 1024 + lane * 8); cbv[rr] = *(const u32x4*)(osc + r * 1024 + 512 + lane * 8); cg[rr] = *(const u32x4*)(gate + r * 512 + lane * 8); }
        __syncthreads();
#pragma unroll
        for (int rr = 0; rr < 8; ++rr) {
            const int i = w * 8 + rr;
            { const u32x4 a = ca[rr], b = cbv[rr], gt = cg[rr];
              float o[8] = {bflo(a.x) + bflo(b.x), bfhi(a.x) + bfhi(b.x), bflo(a.y) + bflo(b.y), bfhi(a.y) + bfhi(b.y), bflo(a.z) + bflo(b.z), bfhi(a.z) + bfhi(b.z), bflo(a.w) + bflo(b.w), bfhi(a.w) + bfhi(b.w)};
              const float gg[8] = {bflo(gt.x), bfhi(gt.x), bflo(gt.y), bfhi(gt.y), bflo(gt.z), bfhi(gt.z), bflo(gt.w), bfhi(gt.w)};
              float sq = 0.f;
#pragma unroll
              for (int e = 0; e < 8; ++e) sq += o[e] * o[e];
              sq += __shfl_xor(sq, 1); sq += __shfl_xor(sq, 2); sq += __shfl_xor(sq, 4); sq += __shfl_xor(sq, 8);
              const float rs = __builtin_amdgcn_rsqf(sq * (1.0f / 128.0f) + RMS_EPS);
#pragma unroll
              for (int e = 0; e < 8; ++e) o[e] = o[e] * rs * hn[e] * gg[e];
              u32x4 wv; wv.x = cvt_pk_bf16(o[0], o[1]); wv.y = cvt_pk_bf16(o[2], o[3]); wv.z = cvt_pk_bf16(o[4], o[5]); wv.w = cvt_pk_bf16(o[6], o[7]);
              *(u32x4*)(mix + (o0 + i) * 1024 + lane * 8) = wv; }
            { const f32x4 y0 = *(const LAS f32x4*)(tile + i * 512 + lane * 8), y1 = *(const LAS f32x4*)(tile + i * 512 + lane * 8 + 4);
              float y[8] = {y0[0], y0[1], y0[2], y0[3], y1[0], y1[1], y1[2], y1[3]};
              float s = 0.f;
#pragma unroll
              for (int e = 0; e < 8; ++e) s += y[e];
#pragma unroll
              for (int o = 32; o >= 1; o >>= 1) s += __shfl_xor(s, o);
              const float mu = s * (1.0f / 512.0f); float q = 0.f;
#pragma unroll
              for (int e = 0; e < 8; ++e) { y[e] -= mu; q += y[e] * y[e]; }
#pragma unroll
              for (int o = 32; o >= 1; o >>= 1) q += __shfl_xor(q, o);
              const float rs = __builtin_amdgcn_rsqf(q * (1.0f / 512.0f) + LN_EPS);
#pragma unroll
              for (int e = 0; e < 8; ++e) y[e] = siluf_(y[e] * rs * lg[e] + lb_[e]);
              u32x4 wv; wv.x = cvt_pk_bf16(y[0], y[1]); wv.y = cvt_pk_bf16(y[2], y[3]); wv.z = cvt_pk_bf16(y[4], y[5]); wv.w = cvt_pk_bf16(y[6], y[7]);
              *(u32x4*)(mix + (o0 + i) * 1024 + 512 + lane * 8) = wv; }
        }
        __syncthreads();
    }
}

__device__ __forceinline__ void phase_final(const Params& p) {
    const float* ss3 = (const float*)(p.ws + OFF_SS) + 3 * (size_t)R;
    const bf16_t* hb = (const bf16_t*)(p.ws + OFF_X);
    const int wave = threadIdx.x >> 6, lane = threadIdx.x & 63;
    f32x4 g[4];
#pragma unroll
    for (int j = 0; j < 4; ++j) g[j] = *(const f32x4*)(p.in[20] + j * 256 + lane * 4);
    for (int r0 = (blockIdx.x * 8 + wave) * 4; r0 < NRC; r0 += gridDim.x * 32) {
        u32x2 h[4][4]; float sv[4];
#pragma unroll
        for (int q = 0; q < 4; ++q) { sv[q] = ss3[r0 + q];
#pragma unroll
            for (int j = 0; j < 4; ++j) h[q][j] = *(const u32x2*)(hb + (size_t)(r0 + q) * 1024 + j * 256 + lane * 4); }
#pragma unroll
        for (int q = 0; q < 4; ++q) {
            float* op = p.out + (size_t)(r0 + q) * 1024;
            const float s = __builtin_amdgcn_rsqf(sv[q] * (1.0f / 1024.0f) + RMS_EPS);
#pragma unroll
            for (int j = 0; j < 4; ++j) { f32x4 x = {bflo(h[q][j].x), bfhi(h[q][j].x), bflo(h[q][j].y), bfhi(h[q][j].y)}; x = x * s * g[j]; *(f32x4*)(op + j * 256 + lane * 4) = x; }
        }
    }
}

#define XB_TMO      128
#define XB_XCNT(j)  (256  + 64 * (j))
#define XB_XSUB(j)  (1280 + 64 * (j))
#define XB_XGEN(j)  (2304 + 64 * (j))
#define XB_TOP      3328
#define XB_TOPGEN   3392
#define XCD_BAR_WORDS 3456
#define XB_SPIN_CAP (1u << 20)
__device__ __forceinline__ unsigned xb_ld(unsigned* p)              { return __hip_atomic_load(p, __ATOMIC_RELAXED, __HIP_MEMORY_SCOPE_AGENT); }
__device__ __forceinline__ unsigned xb_add(unsigned* p, unsigned v) { return __hip_atomic_fetch_add(p, v, __ATOMIC_RELAXED, __HIP_MEMORY_SCOPE_AGENT); }
__device__ __forceinline__ unsigned xb_xcc_id() { return (unsigned)__builtin_amdgcn_s_getreg((3 << 11) | 20) & 0xFu; }
#define XB_SPIN(cond, bar) do { unsigned _sp = 0; while (cond) { __builtin_amdgcn_s_sleep(1); \
    if ((++_sp & 255u) == 0u) { if (xb_ld(&(bar)[XB_TMO])) break; if (_sp > XB_SPIN_CAP) { atomicAdd(&(bar)[XB_TMO], 1u); break; } } } } while (0)
struct XcdBarrier { unsigned* bar; unsigned x; volatile LAS unsigned* st; };
__device__ __forceinline__ XcdBarrier xcd_barrier_post(unsigned* bar, volatile LAS unsigned* st) {
    XcdBarrier b; b.bar = bar; b.x = xb_xcc_id(); b.st = st;
    if (threadIdx.x == 0) (void)xb_add(&bar[XB_XCNT(b.x)], 1u);
    return b;
}
__device__ __forceinline__ void xcd_barrier_complete(unsigned* bar, unsigned x, unsigned& nloc, unsigned& nx) {
    const unsigned G = gridDim.x * gridDim.y * gridDim.z;
    unsigned sum, cnt, mine, sp = 0u;
    for (;;) {
        sum = 0u; cnt = 0u; mine = 0u;
#pragma unroll
        for (unsigned j = 0; j < 16; ++j) { const unsigned c = xb_ld(&bar[XB_XCNT(j)]); sum += c; cnt += (c > 0u) ? 1u : 0u; mine = (j == x) ? c : mine; }
        if (sum == G) break;
        __builtin_amdgcn_s_sleep(1);
        if ((++sp & 255u) == 0u) { if (xb_ld(&bar[XB_TMO])) break; if (sp > XB_SPIN_CAP) { atomicAdd(&bar[XB_TMO], 1u); break; } }
    }
    nloc = mine > 0u ? mine : 1u; nx = cnt > 0u ? cnt : 1u;
}
__device__ __forceinline__ void xcd_barrier(const XcdBarrier& b) {
    asm volatile("s_waitcnt vmcnt(0)" ::: "memory");
    __syncthreads();
    if (threadIdx.x == 0) {
        unsigned* bar = b.bar;
        __builtin_amdgcn_s_waitcnt(0);
        unsigned nloc = b.st[0], nx = b.st[1];
        if (nloc == 0u) { xcd_barrier_complete(bar, b.x, nloc, nx); b.st[0] = nloc; b.st[1] = nx; }
        const unsigned old = xb_add(&bar[XB_XSUB(b.x)], 1u);
        const unsigned gen = old / nloc;
        if (old + 1u == (gen + 1u) * nloc) {
            __builtin_amdgcn_fence(__ATOMIC_RELEASE, "agent");
            asm volatile("s_waitcnt vmcnt(0)" ::: "memory");
            const unsigned og = xb_add(&bar[XB_TOP], 1u);
            const unsigned tg = og / nx;
            if (og + 1u == (tg + 1u) * nx) xb_add(&bar[XB_TOPGEN], 1u);
            else XB_SPIN(xb_ld(&bar[XB_TOPGEN]) == tg, bar);
            __builtin_amdgcn_fence(__ATOMIC_ACQUIRE, "agent");
            xb_add(&bar[XB_XGEN(b.x)], 1u);
            asm volatile("s_waitcnt vmcnt(0)" ::: "memory");
        } else {
            XB_SPIN(xb_ld(&bar[XB_XGEN(b.x)]) == gen, bar);
            __builtin_amdgcn_fence(__ATOMIC_ACQUIRE, "agent");
            asm volatile("s_waitcnt vmcnt(0)" ::: "memory");
        }
    }
    __syncthreads();
}

__global__ void __launch_bounds__(NTHREADS, 2) hymba_fwd(Params p) {
    extern __shared__ __attribute__((aligned(16))) unsigned char lds_raw[];
    LAS unsigned char* lds = (LAS unsigned char*)lds_raw;
    unsigned char* ws = p.ws;
    float* ss = (float*)(ws + OFF_SS);
    bf16_t* hb = (bf16_t*)(ws + OFF_X);
    bf16_t* Y = (bf16_t*)(ws + OFF_Y);
    const int lo = p.ph_lo, hi = p.ph_hi;
#if COOP
    volatile LAS unsigned* xst = (volatile LAS unsigned*)(lds + 131072);
    if (threadIdx.x == 0) { xst[0] = 0u; xst[1] = 0u; }
    __syncthreads();
    const XcdBarrier xbar = xcd_barrier_post((unsigned*)(ws + OFF_BAR), xst);
#endif
#define IN(k) (lo <= (k) && (k) < hi)
#ifdef PROBE_MASK
    unsigned long long tph = __builtin_amdgcn_s_memrealtime();
#define PROBE(k) do { if ((PROBE_MASK >> (k)) & 1) { const unsigned long long t1 = __builtin_amdgcn_s_memrealtime(); while (__builtin_amdgcn_s_memrealtime() - t1 < t1 - tph) __builtin_amdgcn_s_sleep(8); } tph = __builtin_amdgcn_s_memrealtime(); } while (0)
#else
#define PROBE(k) do { } while (0)
#endif
#if COOP
#define SEAM(k) do { if (IN(k) && IN((k) + 1)) xcd_barrier(xbar); PROBE(k); } while (0)
#else
#define SEAM(k) do { } while (0)
#endif
    if (lo < 0) cg::this_grid().sync();
    if (IN(0)) phase_prep(lds, p);
    SEAM(0);
    if (IN(1)) { if (blockIdx.x < 128) meta_stage<2, 8>(lds, p, blockIdx.x);
        EpiPair<0> E{Y, FF, 0, ss, 0}; pg8::gemm_phase(lds, hb, (const bf16_t*)(ws + OFF_W1), NRC, 5632, 1024, E, STAG); }
    SEAM(1);
    if (IN(2)) { EpiRes<0> E{hb, hb, ss + R}; pg8::gemm_phase(lds, Y, (const bf16_t*)(ws + OFF_W2), NRC, 1024, FF, E); }
    SEAM(2);
    if (IN(3)) { if (blockIdx.x < 192) meta_stage<3, 16>(lds, p, blockIdx.x);
        EpiZ E{EpiZa{(bf16_t*)(ws + OFF_Y + Y_Q), (bf16_t*)(ws + OFF_Y + Y_V), (unsigned short*)(ws + OFF_Y + Y_LFO), ss + R, (const float*)(ws + OFF_LB)},
                        EpiZb{(bf16_t*)p.out + (size_t)R * 1024, (bf16_t*)(ws + OFF_Y + Y_GLU), ss + R}};
        pg8::gemm_phase(lds, hb, (const bf16_t*)(ws + OFF_W3A), NRC, 3584, 1024, E, STAG); }
    SEAM(3);
    if (IN(4)) phase_scan(lds, p);
    SEAM(4);
    if (IN(6)) phase_mix(lds, p);
    SEAM(6);
    if (IN(7)) { EpiRes<1> E{hb, (bf16_t*)p.out, ss + 2 * R}; pg8::gemm_phase(lds, (const bf16_t*)(ws + OFF_Y + Y_LFO), (const bf16_t*)(ws + OFF_W4), NRC, 1024, 1024, E); }
    SEAM(7);
    if (IN(8)) { EpiPair<0> E{Y, FF, 0, ss + 2 * R, 0}; pg8::gemm_phase(lds, (const bf16_t*)p.out, (const bf16_t*)(ws + OFF_W5), NRC, 5632, 1024, E, STAG); }
    SEAM(8);
    if (IN(9)) { EpiRes<2> E{(const bf16_t*)p.out, hb, ss + 3 * R}; pg8::gemm_phase(lds, Y, (const bf16_t*)(ws + OFF_W6), NRC, 1024, FF, E); }
    SEAM(9);
    if (IN(10)) phase_final(p);
    PROBE(10);
#undef IN
#undef SEAM
}

extern "C" void kernel_launch(void* const* d_in, const int* in_sizes, int n_in, void* d_out, int out_size, void* d_ws, size_t ws_size, hipStream_t stream) {
    constexpr int LDS_BYTES = 131072 + 16;
    static int grid = 0;
    if (grid == 0) {
        if (n_in != 21 || ws_size < WS_END) { fprintf(stderr, "kernel_launch: need 21 inputs and %zu bytes of workspace; got %d, %zu\n", (size_t)WS_END, n_in, ws_size); grid = -1; return; }
        int dev = 0, cus = 0, per_cu = 0;
        (void)hipGetDevice(&dev); (void)hipDeviceGetAttribute(&cus, hipDeviceAttributeMultiprocessorCount, dev);
        if (hipFuncSetAttribute((const void*)hymba_fwd, hipFuncAttributeMaxDynamicSharedMemorySize, LDS_BYTES) != hipSuccess) { fprintf(stderr, "kernel_launch: hipFuncSetAttribute failed\n"); grid = -1; return; }
        if (hipOccupancyMaxActiveBlocksPerMultiprocessor(&per_cu, (const void*)hymba_fwd, NTHREADS, LDS_BYTES) != hipSuccess || per_cu < 1) per_cu = 1;
        (void)hipGetLastError();
        grid = cus * 1;
        if (grid <= 0) grid = 256;
    }
    if (grid < 0) return;
    if (hipMemsetAsync((char*)d_ws + OFF_BAR, 0, XCD_BAR_WORDS * 4, stream) != hipSuccess) { fprintf(stderr, "kernel_launch: memset of the barrier words failed\n"); return; }
    Params p{};
    for (int i = 0; i < 21; ++i) p.in[i] = (const float*)d_in[i];
    p.out = (float*)d_out; p.ws = (unsigned char*)d_ws;
#if COOP
    p.ph_lo = 0; p.ph_hi = 11;
    void* args[] = {&p};
    hipError_t e = hipLaunchCooperativeKernel((const void*)hymba_fwd, dim3(grid), dim3(NTHREADS), args, LDS_BYTES, stream);
    if (e != hipSuccess) fprintf(stderr, "cooperative launch failed: %s (grid %d)\n", hipGetErrorString(e), grid);
#else
    for (int ph = 0; ph < 11; ++ph) { p.ph_lo = ph; p.ph_hi = ph + 1; hipLaunchKernelGGL(hymba_fwd, dim3(grid), dim3(NTHREADS), LDS_BYTES, stream, p); }
#endif
}
```
